# Optimizing an MI355X kernel written in HIP

```python
import math
import jax, jax.numpy as jnp
from jax import lax
import numpy as np


D_MODEL = 1024
BATCH = 4
SEQ = 4096
DEPTH = 2
DEC_BATCH = 8
DEC_SEQ = 2048
PAST_LEN = 128

GRID_W = 64
HEAD_DIM = 64
N_HEADS = 8
N_KV_HEADS = 2
Q_PER_KV = N_HEADS // N_KV_HEADS
ATTN_W = N_HEADS * HEAD_DIM
KV_W = N_KV_HEADS * HEAD_DIM
CONV_W = 512
MIX_W = ATTN_W + CONV_W
D_IN = ATTN_W + 2 * KV_W + 3 * CONV_W
SPLITS = (ATTN_W, ATTN_W + KV_W, ATTN_W + 2 * KV_W, ATTN_W + 2 * KV_W + CONV_W, ATTN_W + 2 * KV_W + 2 * CONV_W)
D_FF = 2816
CONV_K = 3
PLE_DIM = 256
Q_BLOCK = 128
ROPE_THETA = 10000.0
EPS = 1e-6

kernel_name = "hybrid_bidir_attn_shortconv_encoder"


def rmsnorm(x, g):
    xf = x.astype(jnp.float32)
    y = xf * lax.rsqrt(jnp.mean(xf * xf, axis=-1, keepdims=True) + EPS) * g.astype(jnp.float32)
    return y.astype(x.dtype)


def dwconv3(x, w):
    xp = jnp.pad(x, ((0, 0), (1, 1), (0, 0)))
    return xp[:, :-2] * w[0] + xp[:, 1:-1] * w[1] + xp[:, 2:] * w[2]


def axial_rope_tables(seq_len):
    rows = seq_len // GRID_W
    row = jnp.repeat(jnp.arange(rows), GRID_W).astype(jnp.float32)
    col = jnp.tile(jnp.arange(GRID_W), rows).astype(jnp.float32)
    half = HEAD_DIM // 2
    freqs = ROPE_THETA ** (-jnp.arange(0, half, 2, dtype=jnp.float32) / half)
    ang_r = row[:, None] * freqs[None, :]
    ang_c = col[:, None] * freqs[None, :]
    ang = jnp.concatenate([ang_r, ang_r, ang_c, ang_c], axis=-1)
    return jnp.cos(ang), jnp.sin(ang)


def apply_axial_rope(x, cos, sin):
    q4 = HEAD_DIM // 4
    x1, x2, x3, x4 = x[..., :q4], x[..., q4:2 * q4], x[..., 2 * q4:3 * q4], x[..., 3 * q4:]
    rot = jnp.concatenate([-x2, x1, -x4, x3], axis=-1)
    c = cos[None, :, None, :].astype(x.dtype)
    s = sin[None, :, None, :].astype(x.dtype)
    return x * c + rot * s


def bidir_gqa(q, k, v):
    B, S = q.shape[0], q.shape[1]
    nb = S // Q_BLOCK
    scale = 1.0 / math.sqrt(HEAD_DIM)
    qb = q.reshape(B, nb, Q_BLOCK, N_KV_HEADS, Q_PER_KV, HEAD_DIM).transpose(1, 0, 2, 3, 4, 5)

    def block(qi):
        s = jnp.einsum('bqkgd,bskd->bkgqs', qi, k).astype(jnp.float32) * scale
        p = jax.nn.softmax(s, axis=-1).astype(v.dtype)
        return jnp.einsum('bkgqs,bskd->bqkgd', p, v)

    o = lax.map(block, qb)
    return o.transpose(1, 0, 2, 3, 4, 5).reshape(B, S, ATTN_W)


def trunk(x, p, attn_norm_g, w_in, q_norm_g, k_norm_g, mix_conv_w, attn_out_g, conv_out_g,
          w_out, ffn_norm_g, w_up, ffn_conv_w, w_down, w_ple_gate, w_ple_proj):
    B, S, _ = x.shape
    cos, sin = axial_rope_tables(S)
    h = x
    for i in range(DEPTH):
        a = rmsnorm(h, attn_norm_g[i])
        z = a @ w_in[i]
        q, k, v, gb, gc, u = jnp.split(z, SPLITS, axis=-1)
        q = q.reshape(B, S, N_HEADS, HEAD_DIM)
        k = k.reshape(B, S, N_KV_HEADS, HEAD_DIM)
        v = v.reshape(B, S, N_KV_HEADS, HEAD_DIM)
        q = apply_axial_rope(rmsnorm(q, q_norm_g[i]), cos, sin)
        k = apply_axial_rope(rmsnorm(k, k_norm_g[i]), cos, sin)
        o_attn = bidir_gqa(q, k, v)
        o_conv = gb * dwconv3(gc * u, mix_conv_w[i])
        mixed = jnp.concatenate([rmsnorm(o_attn, attn_out_g[i]), rmsnorm(o_conv, conv_out_g[i])], axis=-1)
        h = h + mixed @ w_out[i]
        f = dwconv3(rmsnorm(h, ffn_norm_g[i]) @ w_up[i], ffn_conv_w[i])
        g, up = jnp.split(f, 2, axis=-1)
        h = h + (jax.nn.silu(g) * up) @ w_down[i]
        h = h + jax.nn.sigmoid(h @ w_ple_gate[i]) * (p[i] @ w_ple_proj[i])
    return h


def setup_inputs(seed: int = 0) -> dict:
    key = jax.random.key(seed)
    ks = jax.random.split(key, 20)
    f32 = jnp.float32

    def nrm(k, shape, scale):
        return jax.random.normal(k, shape, f32) * scale

    def gain(k, shape):
        return 1.0 + 0.01 * jax.random.normal(k, shape, f32)

    return {
        "x_prompt": nrm(ks[0], (BATCH, SEQ, D_MODEL), 1.0),
        "x_sample": nrm(ks[1], (DEC_BATCH, DEC_SEQ, D_MODEL), 1.0),
        "p_prompt": nrm(ks[2], (DEPTH, BATCH, SEQ, PLE_DIM), 1.0),
        "p_sample": nrm(ks[3], (DEPTH, DEC_BATCH, DEC_SEQ, PLE_DIM), 1.0),
        "attn_norm_g": gain(ks[4], (DEPTH, D_MODEL)),
        "w_in": nrm(ks[5], (DEPTH, D_MODEL, D_IN), D_MODEL ** -0.5),
        "q_norm_g": gain(ks[6], (DEPTH, HEAD_DIM)),
        "k_norm_g": gain(ks[7], (DEPTH, HEAD_DIM)),
        "mix_conv_w": nrm(ks[8], (DEPTH, CONV_K, CONV_W), CONV_K ** -0.5),
        "attn_out_g": gain(ks[9], (DEPTH, ATTN_W)),
        "conv_out_g": gain(ks[10], (DEPTH, CONV_W)),
        "w_out": nrm(ks[11], (DEPTH, MIX_W, D_MODEL), MIX_W ** -0.5),
        "ffn_norm_g": gain(ks[12], (DEPTH, D_MODEL)),
        "w_up": nrm(ks[13], (DEPTH, D_MODEL, 2 * D_FF), D_MODEL ** -0.5),
        "ffn_conv_w": nrm(ks[14], (DEPTH, CONV_K, 2 * D_FF), CONV_K ** -0.5),
        "w_down": nrm(ks[15], (DEPTH, D_FF, D_MODEL), D_FF ** -0.5),
        "w_ple_gate": nrm(ks[16], (DEPTH, D_MODEL, D_MODEL), D_MODEL ** -0.5),
        "w_ple_proj": nrm(ks[17], (DEPTH, PLE_DIM, D_MODEL), PLE_DIM ** -0.5),
    }


def reference(x_prompt, x_sample, p_prompt, p_sample, attn_norm_g, w_in, q_norm_g, k_norm_g,
              mix_conv_w, attn_out_g, conv_out_g, w_out, ffn_norm_g, w_up, ffn_conv_w, w_down,
              w_ple_gate, w_ple_proj):
    y_prompt = trunk(x_prompt, p_prompt, attn_norm_g, w_in, q_norm_g, k_norm_g, mix_conv_w,
                     attn_out_g, conv_out_g, w_out, ffn_norm_g, w_up, ffn_conv_w, w_down,
                     w_ple_gate, w_ple_proj)
    y_sample = trunk(x_sample, p_sample, attn_norm_g, w_in, q_norm_g, k_norm_g, mix_conv_w,
                     attn_out_g, conv_out_g, w_out, ffn_norm_g, w_up, ffn_conv_w, w_down,
                     w_ple_gate, w_ple_proj)
    return (y_prompt, y_sample)
```

```cpp
#include <hip/hip_runtime.h>
#include <hip/hip_cooperative_groups.h>
#include <cstdio>
#include <cstdint>
namespace cg = cooperative_groups;
namespace pg8 {
#define PG8_LAS __attribute__((address_space(3)))
typedef unsigned short bf16_t;
typedef short bf16x8 __attribute__((ext_vector_type(8)));
typedef float f32x4 __attribute__((ext_vector_type(4)));
typedef unsigned u32x4 __attribute__((ext_vector_type(4)));
constexpr int BM = 256, BK = 64, HALF = 128, HTB = HALF * BK * 2  , STAGE_BYTES = 8 * HTB, NXCD = 8, WGM = 8;

__host__ __device__ __forceinline__ int lds_byte(int r, int c) { const int st = (r >> 4) * 2 + (c >> 5), rr = r & 15, cc = c & 31, ob = rr * 64 + cc * 2; return st * 1024 + (ob ^ (((ob >> 9) & 1) << 5)); }
__host__ __device__ __forceinline__ void stage_rc(int b, int& R, int& C) { const int st = b / 1024, sb = b % 1024, swz = sb ^ (((sb >> 9) & 1) << 5); R = (st >> 1) * 16 + swz / 64; C = (st & 1) * 32 + (swz % 64) / 2; }
__host__ __device__ __forceinline__ int perm32(int rho) { const int n = rho >> 4, i = rho & 15; return 8 * (i >> 2) + 4 * n + (i & 3); }

struct Unit { int pm, pn; };
struct Gemm { const bf16_t* A; const bf16_t* Bt; int M, N, K; };

struct StaticOrder {
    int nM, nN, nwg, G, c;
    __host__ __device__ void init(int M, int N, int G_, int c_) { nM = M / BM; nN = N / BM; nwg = nM * nN; G = G_; c = c_; }
    __host__ __device__ bool next(int i, Unit& u) const {
        const long L = (long)i * G + c; if (L >= nwg) return false;
        int wgid = (int)L; { const int q = nwg / NXCD, r = nwg % NXCD, xcd = wgid % NXCD, off = wgid / NXCD; wgid = (xcd < r ? xcd * (q + 1) : r * (q + 1) + (xcd - r) * q) + off; }
        const int nig = WGM * nN, gid = wgid / nig, fm = gid * WGM, gsz = (nM - fm) < WGM ? (nM - fm) : WGM;
        u.pm = fm + ((wgid % nig) % gsz); u.pn = (wgid % nig) / gsz; return true;
    }
    __device__ __forceinline__ void a_ready(const Unit&) const {}
    __device__ __forceinline__ void done(const Unit&) const {}
};

__device__ __forceinline__ unsigned cvt_pk_bf16(float lo, float hi) { unsigned r; asm volatile("v_cvt_pk_bf16_f32 %0, %1, %2" : "=v"(r) : "v"(lo), "v"(hi)); return r; }
typedef float f32x2 __attribute__((ext_vector_type(2)));

typedef unsigned u32x2 __attribute__((ext_vector_type(2)));
__device__ __forceinline__ float bf_lo(unsigned w) { return __uint_as_float(w << 16); }
__device__ __forceinline__ float bf_hi(unsigned w) { return __uint_as_float(w & 0xffff0000u); }
__device__ __forceinline__ float dpp_ror1(float x)  { return __int_as_float(__builtin_amdgcn_update_dpp(0, __float_as_int(x), 0x121, 0xf, 0xf, false)); }
__device__ __forceinline__ float dpp_ror15(float x) { return __int_as_float(__builtin_amdgcn_update_dpp(0, __float_as_int(x), 0x12f, 0xf, 0xf, false)); }
__device__ __forceinline__ float dpp_shr1(float old, float x) { return __int_as_float(__builtin_amdgcn_update_dpp(__float_as_int(old), __float_as_int(x), 0x111, 0xf, 0xf, false)); }
__device__ __forceinline__ float dpp_shl1(float old, float x) { return __int_as_float(__builtin_amdgcn_update_dpp(__float_as_int(old), __float_as_int(x), 0x101, 0xf, 0xf, false)); }

struct EpiStoreBf16 {
    static constexpr bool PERM = true, AFTER_DRAIN = false;
    bf16_t* O; int ldc;
    __device__ __forceinline__ void operator()(const f32x4 (&acc)[2][2][4][2], const Unit& u, int wr, int wc, int fr, int fq) const {
        const int row0 = u.pm * BM + wr * 64 + fr, col0 = u.pn * BM + wc * 32 + 8 * fq;
#pragma unroll
        for (int ai = 0; ai < 2; ++ai)
#pragma unroll
            for (int m = 0; m < 4; ++m) { bf16_t* rowp = O + (size_t)(row0 + ai * HALF + m * 16) * ldc + col0;
#pragma unroll
                for (int bj = 0; bj < 2; ++bj) { const f32x4 v0 = acc[ai][bj][m][0], v1 = acc[ai][bj][m][1];
                    u32x4 w; w.x = cvt_pk_bf16(v0[0], v0[1]); w.y = cvt_pk_bf16(v0[2], v0[3]); w.z = cvt_pk_bf16(v1[0], v1[1]); w.w = cvt_pk_bf16(v1[2], v1[3]);
                    *(u32x4*)(rowp + bj * HALF) = w; } }
    }
};
template <bool WITH_BF16> struct EpiResF32 {
    static constexpr bool PERM = false, AFTER_DRAIN = false;
    const float* base_lo; const float* base_hi; float* out; bf16_t* hb;
    __device__ __forceinline__ void operator()(const f32x4 (&acc)[2][2][4][2], const Unit& u, int wr, int wc, int fr, int fq) const {
        const float* base = (u.pm < 64) ? base_lo : base_hi;
        const int col0 = u.pn * BM + wc * 32 + 4 * fq;
#pragma unroll
        for (int ai = 0; ai < 2; ++ai)
#pragma unroll
            for (int m = 0; m < 4; ++m) { const size_t off = (size_t)(u.pm * BM + ai * HALF + wr * 64 + m * 16 + fr) * 1024 + col0;
#pragma unroll
                for (int bj = 0; bj < 2; ++bj)
#pragma unroll
                    for (int n = 0; n < 2; ++n) { const f32x4 o = *(const f32x4*)(base + off + bj * HALF + n * 16) + acc[ai][bj][m][n];
                        *(f32x4*)(out + off + bj * HALF + n * 16) = o;
                        if (WITH_BF16) { u32x2 w; w.x = cvt_pk_bf16(o[0], o[1]); w.y = cvt_pk_bf16(o[2], o[3]); *(u32x2*)(hb + off + bj * HALF + n * 16) = w; } }
                asm volatile("" ::: "memory"); }
    }
};
struct EpiGate {
    static constexpr bool PERM = false, AFTER_DRAIN = false;
    float* out; const bf16_t* pp;
    __device__ __forceinline__ void operator()(const f32x4 (&acc)[2][2][4][2], const Unit& u, int wr, int wc, int fr, int fq) const {
        const int col0 = u.pn * BM + wc * 32 + 4 * fq;
#pragma unroll
        for (int ai = 0; ai < 2; ++ai)
#pragma unroll
            for (int m = 0; m < 4; ++m) { const size_t off = (size_t)(u.pm * BM + ai * HALF + wr * 64 + m * 16 + fr) * 1024 + col0;
#pragma unroll
                for (int bj = 0; bj < 2; ++bj)
#pragma unroll
                    for (int n = 0; n < 2; ++n) { const f32x4 h = *(const f32x4*)(out + off + bj * HALF + n * 16); const u32x2 pw = *(const u32x2*)(pp + off + bj * HALF + n * 16);
                        const f32x4 a = acc[ai][bj][m][n]; f32x4 o;
                        const float p0 = bf_lo(pw.x), p1 = bf_hi(pw.x), p2 = bf_lo(pw.y), p3 = bf_hi(pw.y);
                        o[0] = h[0] + p0 * __builtin_amdgcn_rcpf(1.f + __builtin_amdgcn_exp2f(-1.4426950408889634f * a[0]));
                        o[1] = h[1] + p1 * __builtin_amdgcn_rcpf(1.f + __builtin_amdgcn_exp2f(-1.4426950408889634f * a[1]));
                        o[2] = h[2] + p2 * __builtin_amdgcn_rcpf(1.f + __builtin_amdgcn_exp2f(-1.4426950408889634f * a[2]));
                        o[3] = h[3] + p3 * __builtin_amdgcn_rcpf(1.f + __builtin_amdgcn_exp2f(-1.4426950408889634f * a[3]));
                        *(f32x4*)(out + off + bj * HALF + n * 16) = o; }
                asm volatile("" ::: "memory"); }
    }
};
struct EpiConvAct {
    static constexpr bool PERM = true, AFTER_DRAIN = false;
    bf16_t* act; bf16_t* E; const float* cw; PG8_LAS float* H;
    __device__ __forceinline__ void operator()(const f32x4 (&acc)[2][2][4][2], const Unit& u, int wr, int wc, int fr, int fq) const {
        const int ch0 = u.pn * 128 + wc * 32 + 8 * fq;
#pragma unroll
        for (int ai = 0; ai < 2; ++ai) { const int seg = 2 * ai + wr;
            if (fr == 0)  { PG8_LAS f32x4* h = (PG8_LAS f32x4*)(H + ((((seg * 2 + 0) * 4 + wc) * 4 + fq) * 16)); h[0] = acc[ai][0][0][0]; h[1] = acc[ai][0][0][1]; h[2] = acc[ai][1][0][0]; h[3] = acc[ai][1][0][1]; }
            if (fr == 15) { PG8_LAS f32x4* h = (PG8_LAS f32x4*)(H + ((((seg * 2 + 1) * 4 + wc) * 4 + fq) * 16)); h[0] = acc[ai][0][3][0]; h[1] = acc[ai][0][3][1]; h[2] = acc[ai][1][3][0]; h[3] = acc[ai][1][3][1]; } }
        asm volatile("s_waitcnt lgkmcnt(0)" ::: "memory"); __builtin_amdgcn_s_barrier(); asm volatile("" ::: "memory");
#pragma unroll
        for (int n = 0; n < 2; ++n) {
            f32x4 w[2][3];
#pragma unroll
            for (int bj = 0; bj < 2; ++bj)
#pragma unroll
                for (int j = 0; j < 3; ++j) w[bj][j] = *(const f32x4*)(cw + j * 5632 + bj * 2816 + ch0 + 4 * n);
#pragma unroll
            for (int ai = 0; ai < 2; ++ai) { const int seg = 2 * ai + wr;
                f32x4 hp[2], hn[2];
                { const int sp = seg > 0 ? seg - 1 : 0; const PG8_LAS f32x4* h = (const PG8_LAS f32x4*)(H + ((((sp * 2 + 1) * 4 + wc) * 4 + fq) * 16)); hp[0] = h[n]; hp[1] = h[2 + n];
                  if (seg == 0) { hp[0] = (f32x4){0.f, 0.f, 0.f, 0.f}; hp[1] = hp[0]; } }
                { const int sn = seg < 3 ? seg + 1 : 3; const PG8_LAS f32x4* h = (const PG8_LAS f32x4*)(H + ((((sn * 2 + 0) * 4 + wc) * 4 + fq) * 16)); hn[0] = h[n]; hn[1] = h[2 + n];
                  if (seg == 3) { hn[0] = (f32x4){0.f, 0.f, 0.f, 0.f}; hn[1] = hn[0]; } }
#pragma unroll
                for (int m = 0; m < 4; ++m) {
                    f32x4 cv[2];
#pragma unroll
                    for (int bj = 0; bj < 2; ++bj) { const f32x4 cur = acc[ai][bj][m][n];
#pragma unroll
                        for (int i = 0; i < 4; ++i) {
                            const float X = (m > 0) ? dpp_ror1(acc[ai][bj][m > 0 ? m - 1 : 0][n][i]) : hp[bj][i];
                            const float Y = (m < 3) ? dpp_ror15(acc[ai][bj][m < 3 ? m + 1 : 3][n][i]) : hn[bj][i];
                            const float prv = dpp_shr1(X, cur[i]), nxt = dpp_shl1(Y, cur[i]);
                            cv[bj][i] = w[bj][0][i] * prv + w[bj][1][i] * cur[i] + w[bj][2][i] * nxt; } }
                    float o[4];
#pragma unroll
                    for (int i = 0; i < 4; ++i) o[i] = cv[0][i] * __builtin_amdgcn_rcpf(1.f + __builtin_amdgcn_exp2f(-1.4426950408889634f * cv[0][i])) * cv[1][i];
                    u32x2 pw; pw.x = cvt_pk_bf16(o[0], o[1]); pw.y = cvt_pk_bf16(o[2], o[3]);
                    *(u32x2*)(act + (size_t)(u.pm * BM + ai * HALF + wr * 64 + m * 16 + fr) * 2816 + ch0 + 4 * n) = pw;
                }
            }
            if (wr == 0 && fr < 2) {
#pragma unroll
                for (int bj = 0; bj < 2; ++bj) { const f32x4 v = acc[0][bj][0][n]; u32x2 pw; pw.x = cvt_pk_bf16(v[0], v[1]); pw.y = cvt_pk_bf16(v[2], v[3]);
                    *(u32x2*)(E + (size_t)(u.pm * 4 + fr) * 5632 + bj * 2816 + ch0 + 4 * n) = pw; } }
            if (wr == 1 && fr >= 14) {
#pragma unroll
                for (int bj = 0; bj < 2; ++bj) { const f32x4 v = acc[1][bj][3][n]; u32x2 pw; pw.x = cvt_pk_bf16(v[0], v[1]); pw.y = cvt_pk_bf16(v[2], v[3]);
                    *(u32x2*)(E + (size_t)(u.pm * 4 + fr - 12) * 5632 + bj * 2816 + ch0 + 4 * n) = pw; } }
        }
    }
};
template <class Epi, class Sched, bool ALIGN_EPI = false, bool SP2 = false>
__device__ __forceinline__ void gemm_phase(PG8_LAS unsigned char* lds, const Gemm g, const Sched& S, const Epi& E) {
    int tid_ = threadIdx.x; asm volatile("" : "+v"(tid_));
    const int tid = tid_, wid = __builtin_amdgcn_readfirstlane(tid >> 6), lane = tid & 63, wr = wid >> 2, wc = wid & 3, fr = lane & 15, fq = lane >> 4;
    const int K = g.K, nt = K / BK;
    unsigned voffA[2], voffB[2];
#pragma unroll
    for (int i = 0; i < 2; ++i) { int R, C; stage_rc(tid * 16 + i * 8192, R, C); const int Rb = Epi::PERM ? ((R & ~31) + perm32(R & 31)) : R;
        voffA[i] = (unsigned)(R * K + C) * 2u; voffB[i] = (unsigned)(Rb * K + C) * 2u; }
    const size_t kstep = (size_t)(BK * 2);
    const size_t hstep = (size_t)HALF * K * 2;
    const size_t tstep = 2 * hstep;
    const unsigned ldsw = (unsigned)wid * 1024u;
    const int aoff = lds_byte(wr * 64 + fr, fq * 8), boff = lds_byte(wc * 32 + fr, fq * 8);
#define PG8_SA(b, h) (((b) * 2 + (h)) * HTB)
#define PG8_SB(b, h) ((4 + (b) * 2 + (h)) * HTB)
#define PG8_STAGE(bufoff, gbase, voff) do { _Pragma("unroll") for (int _i = 0; _i < 2; ++_i) \
        __builtin_amdgcn_global_load_lds((const unsigned*)((const char*)(gbase) + (voff)[_i]), (PG8_LAS unsigned*)(lds + (bufoff) + ldsw + _i * 8192), 16, 0, 0); } while (0)
#define PG8_LDA(dst, b, h) do { _Pragma("unroll") for (int m = 0; m < 4; ++m) _Pragma("unroll") for (int k = 0; k < 2; ++k) dst[m][k] = *(const PG8_LAS bf16x8*)(lds + PG8_SA(b, h) + aoff + m * 2048 + k * 1024); } while (0)
#define PG8_LDB(dst, b, h) do { _Pragma("unroll") for (int n = 0; n < 2; ++n) _Pragma("unroll") for (int k = 0; k < 2; ++k) dst[n][k] = *(const PG8_LAS bf16x8*)(lds + PG8_SB(b, h) + boff + n * 2048 + k * 1024); } while (0)
#define PG8_MMA(ai, bj, At, Bt) do { __builtin_amdgcn_s_setprio(1); _Pragma("unroll") for (int m = 0; m < 4; ++m) _Pragma("unroll") for (int n = 0; n < 2; ++n) _Pragma("unroll") for (int k = 0; k < 2; ++k) \
        acc[ai][bj][m][n] = __builtin_amdgcn_mfma_f32_16x16x32_bf16(Bt[n][k], At[m][k], acc[ai][bj][m][n], 0, 0, 0); __builtin_amdgcn_s_setprio(0); } while (0)
#define PG8_WAIT_V(n) asm volatile("s_waitcnt vmcnt(" #n ")" ::: "memory")
#define PG8_WAIT_L(n) asm volatile("s_waitcnt lgkmcnt(" #n ")" ::: "memory")
#define PG8_BAR __builtin_amdgcn_s_barrier()
#define PG8_SCHED __builtin_amdgcn_sched_barrier(0)
    Unit cur, nxt; int ui = 0;
    if (!S.next(0, cur)) return;
    f32x4 acc[2][2][4][2];
#pragma unroll
    for (int a = 0; a < 2; ++a)
#pragma unroll
        for (int b = 0; b < 2; ++b)
#pragma unroll
            for (int m = 0; m < 4; ++m)
#pragma unroll
                for (int n = 0; n < 2; ++n) acc[a][b][m][n] = (f32x4){0.f, 0.f, 0.f, 0.f};
    bf16x8 At[4][2], B0[2][2], B1[2][2];
    const char* cA = (const char*)g.A + (size_t)cur.pm * tstep; const char* cB = (const char*)g.Bt + (size_t)cur.pn * tstep;
    S.a_ready(cur);
    if constexpr (SP2) {
        PG8_STAGE(PG8_SB(0, 0), cB, voffB); PG8_STAGE(PG8_SB(0, 1), cB + hstep, voffB); PG8_STAGE(PG8_SA(0, 0), cA, voffA); PG8_STAGE(PG8_SA(0, 1), cA + hstep, voffA);
        if (wr == 1) PG8_BAR;
        PG8_WAIT_V(2); PG8_BAR;
        PG8_STAGE(PG8_SB(1, 0), cB + kstep, voffB); PG8_STAGE(PG8_SA(1, 0), cA + kstep, voffA); PG8_STAGE(PG8_SB(1, 1), cB + hstep + kstep, voffB);
        PG8_WAIT_V(6); PG8_BAR;
    } else {
        PG8_STAGE(PG8_SB(0, 0), cB, voffB); PG8_STAGE(PG8_SA(0, 0), cA, voffA); PG8_STAGE(PG8_SB(0, 1), cB + hstep, voffB); PG8_STAGE(PG8_SA(0, 1), cA + hstep, voffA);
        if (wr == 1) PG8_BAR;
        PG8_WAIT_V(4); PG8_BAR;
        PG8_STAGE(PG8_SB(1, 0), cB + kstep, voffB); PG8_STAGE(PG8_SA(1, 0), cA + kstep, voffA); PG8_STAGE(PG8_SB(1, 1), cB + hstep + kstep, voffB);
        PG8_WAIT_V(6); PG8_BAR;
    }
    for (;;) {
        const bool has_next = S.next(ui + 1, nxt);
        const char* nA = has_next ? (const char*)g.A + (size_t)nxt.pm * tstep : cA; const char* nB = has_next ? (const char*)g.Bt + (size_t)nxt.pn * tstep : cB;
        for (int t = 0; t < nt; t += 2) {
            const bool last = (t == nt - 2);
            const char* a1 = cA + (size_t)(t + 1) * kstep;
            const char* a2 = last ? nA : cA + (size_t)(t + 2) * kstep; const char* b2 = last ? nB : cB + (size_t)(t + 2) * kstep;
            const char* a3 = a2 + kstep; const char* b3 = b2 + kstep;
            if (last && has_next) S.a_ready(nxt);
            if constexpr (SP2) {
            PG8_LDB(B0, 0, 0); PG8_LDB(B1, 0, 1); PG8_SCHED; PG8_LDA(At, 0, 0); PG8_STAGE(PG8_SA(1, 1), a1 + hstep, voffA);
            PG8_WAIT_V(8); PG8_WAIT_L(0); PG8_BAR; PG8_MMA(0, 0, At, B0); PG8_MMA(0, 1, At, B1); PG8_BAR; PG8_SCHED;
            PG8_LDA(At, 0, 1); PG8_STAGE(PG8_SB(0, 0), b2, voffB); PG8_STAGE(PG8_SB(0, 1), b2 + hstep, voffB); PG8_STAGE(PG8_SA(0, 0), a2, voffA);
            PG8_WAIT_V(8); PG8_WAIT_L(0); PG8_BAR; PG8_MMA(1, 0, At, B0); PG8_MMA(1, 1, At, B1); PG8_BAR; PG8_SCHED;
            PG8_LDB(B0, 1, 0); PG8_LDB(B1, 1, 1); PG8_SCHED; PG8_LDA(At, 1, 0); PG8_STAGE(PG8_SA(0, 1), a2 + hstep, voffA);
            PG8_WAIT_V(8); PG8_WAIT_L(0); PG8_BAR; PG8_MMA(0, 0, At, B0); PG8_MMA(0, 1, At, B1); PG8_BAR; PG8_SCHED;
            PG8_LDA(At, 1, 1); PG8_STAGE(PG8_SB(1, 0), b3, voffB); PG8_STAGE(PG8_SB(1, 1), b3 + hstep, voffB); PG8_STAGE(PG8_SA(1, 0), a3, voffA);
            PG8_WAIT_V(8); PG8_WAIT_L(0); PG8_BAR; PG8_MMA(1, 0, At, B0); PG8_MMA(1, 1, At, B1); PG8_BAR; PG8_SCHED;
            } else {
            PG8_LDB(B0, 0, 0); PG8_SCHED; PG8_LDA(At, 0, 0); PG8_STAGE(PG8_SA(1, 1), a1 + hstep, voffA);
            PG8_WAIT_L(8); PG8_BAR; PG8_WAIT_L(0); PG8_MMA(0, 0, At, B0); PG8_BAR; PG8_SCHED;
            PG8_LDB(B1, 0, 1); PG8_STAGE(PG8_SB(0, 0), b2, voffB);
            PG8_BAR; PG8_WAIT_L(0); PG8_MMA(0, 1, At, B1); PG8_BAR;
            PG8_LDA(At, 0, 1); PG8_STAGE(PG8_SA(0, 0), a2, voffA);
            PG8_BAR; PG8_WAIT_L(0); PG8_MMA(1, 0, At, B0); PG8_BAR; PG8_SCHED;
            PG8_STAGE(PG8_SB(0, 1), b2 + hstep, voffB);
            PG8_WAIT_V(6); PG8_BAR; PG8_MMA(1, 1, At, B1); PG8_BAR;
            PG8_LDB(B0, 1, 0); PG8_SCHED; PG8_LDA(At, 1, 0); PG8_STAGE(PG8_SA(0, 1), a2 + hstep, voffA);
            PG8_WAIT_L(8); PG8_BAR; PG8_WAIT_L(0); PG8_MMA(0, 0, At, B0); PG8_BAR; PG8_SCHED;
            PG8_LDB(B1, 1, 1); PG8_STAGE(PG8_SB(1, 0), b3, voffB);
            PG8_BAR; PG8_WAIT_L(0); PG8_MMA(0, 1, At, B1); PG8_BAR;
            PG8_LDA(At, 1, 1); PG8_STAGE(PG8_SA(1, 0), a3, voffA);
            PG8_BAR; PG8_WAIT_L(0); PG8_MMA(1, 0, At, B0); PG8_BAR; PG8_SCHED;
            PG8_STAGE(PG8_SB(1, 1), b3 + hstep, voffB);
            PG8_WAIT_V(6); PG8_BAR; PG8_MMA(1, 1, At, B1); PG8_BAR;
            }
        }
        if constexpr (ALIGN_EPI) { if (wr == 0) PG8_BAR; }
        if constexpr (!Epi::AFTER_DRAIN) { E(acc, cur, wr, wc, fr, fq); S.done(cur); }
        if (!has_next) break;
#pragma unroll
        for (int a = 0; a < 2; ++a)
#pragma unroll
            for (int b = 0; b < 2; ++b)
#pragma unroll
                for (int m = 0; m < 4; ++m)
#pragma unroll
                    for (int n = 0; n < 2; ++n) acc[a][b][m][n] = (f32x4){0.f, 0.f, 0.f, 0.f};
        cur = nxt; cA = nA; cB = nB; ++ui;
        if constexpr (ALIGN_EPI) { if (wr == 1) PG8_BAR; }
    }
    PG8_WAIT_V(0);
    if constexpr (!ALIGN_EPI) { if (wr == 0) PG8_BAR; }
    PG8_BAR;
    if constexpr (Epi::AFTER_DRAIN) { E.fused(acc, cur, wr, wc, fr, fq, lds, wid, lane); S.done(cur); }
#undef PG8_SA
#undef PG8_SB
#undef PG8_STAGE
#undef PG8_LDA
#undef PG8_LDB
#undef PG8_MMA
#undef PG8_WAIT_V
#undef PG8_WAIT_L
#undef PG8_BAR
#undef PG8_SCHED
}
}
#include <hip/hip_bf16.h>
#include <cmath>
namespace attn_body {
using bf16=__hip_bfloat16;
using bf16x8=__attribute__((ext_vector_type(8)))short;
using s16x4=__attribute__((ext_vector_type(4)))short;
using f32x16=__attribute__((ext_vector_type(16)))float;
using u32x4=__attribute__((ext_vector_type(4)))unsigned;
constexpr int D=64,ZP=2304,OP=1024;
constexpr int NW=8,QBLK=32,QB=QBLK*NW,KVBLK=64;
__device__ __forceinline__ int crow(int r,int hi){return (r&3)+8*(r>>2)+4*hi;}
#define SBAR() __builtin_amdgcn_sched_barrier(0)
__device__ __forceinline__ void cmask(f32x16&p0,f32x16&p1,int jb,int qrel,int hi){
  const float NEG=-INFINITY; int kb=64*jb+4*hi;
  #pragma unroll
  for(int r=0;r<16;++r){int kv=kb+(r&3)+8*(r>>2); if(kv>qrel)p0[r]=NEG; if(kv+32>qrel)p1[r]=NEG;}
}

constexpr int NSLOT=3, SLOTB=8192;
constexpr int LDS_K=0, LDS_V=NSLOT*SLOTB, LDS_WS=2*NSLOT*SLOTB, LDS_OST=LDS_WS+NW*64*4, LDS_BYTES=LDS_OST+NW*4096;
constexpr float C2=0.125f*1.4426950408889634f;
__device__ __forceinline__ void glds16(const void*gsrc,unsigned lds_dst){unsigned keep;
  asm volatile("s_mov_b32 %0, m0\n\ts_mov_b32 m0, %2\n\ts_nop 0\n\tglobal_load_lds_dwordx4 %1, off\n\ts_mov_b32 m0, %0":"=&s"(keep):"v"(gsrc),"s"(lds_dst):"memory");}
__device__ __forceinline__ float max3f(float a,float b,float c){float r;asm("v_max3_f32 %0, %1, %2, %3":"=v"(r):"v"(a),"v"(b),"v"(c));return r;}
__device__ __forceinline__ float max2f(float a,float b){float r;asm("v_max_f32_e32 %0, %1, %2":"=v"(r):"v"(a),"v"(b));return r;}
__device__ __forceinline__ float fadd_s(float a,float b){float r;asm("v_add_f32_e32 %0, %1, %2":"=v"(r):"v"(a),"v"(b));return r;}
__device__ __forceinline__ float fsub_s(float a,float b){float r;asm("v_sub_f32_e32 %0, %1, %2":"=v"(r):"v"(a),"v"(b));return r;}
typedef float f32x2_t __attribute__((ext_vector_type(2))); typedef __bf16 bf16x2_t __attribute__((ext_vector_type(2)));
__device__ __forceinline__ unsigned cvtpk_s(float lo,float hi){f32x2_t v={lo,hi};bf16x2_t b=__builtin_convertvector(v,bf16x2_t);return __builtin_bit_cast(unsigned,b);}
#define WAIT_BAR(N) asm volatile("s_waitcnt vmcnt(" #N ") lgkmcnt(0)\n\ts_barrier":::"memory")

__device__ __forceinline__ void qkt(f32x16&p0,f32x16&p1,const char*Kslot,const bf16x8*qr,const f32x16&negm,int r32,int hi){
  const char*kb=Kslot+hi*1024+r32*16;
  #pragma unroll
  for(int d0=0;d0<4;++d0){
    const bf16x8 b0=*reinterpret_cast<const bf16x8*>(kb+d0*2048);
    const bf16x8 b1=*reinterpret_cast<const bf16x8*>(kb+d0*2048+512);
    if(d0==0){p0=__builtin_amdgcn_mfma_f32_32x32x16_bf16(b0,qr[0],negm,0,0,0);p1=__builtin_amdgcn_mfma_f32_32x32x16_bf16(b1,qr[0],negm,0,0,0);}
    else{p0=__builtin_amdgcn_mfma_f32_32x32x16_bf16(b0,qr[d0],p0,0,0,0);p1=__builtin_amdgcn_mfma_f32_32x32x16_bf16(b1,qr[d0],p1,0,0,0);}}
}
typedef __attribute__((address_space(3))) const char* lds_cptr;
typedef short v4i16_t __attribute__((ext_vector_type(4)));
__device__ __forceinline__ void kload8(bf16x8*kf,lds_cptr kp){
  kf[0]=*(const __attribute__((address_space(3))) bf16x8*)(kp);      kf[1]=*(const __attribute__((address_space(3))) bf16x8*)(kp+512);
  kf[2]=*(const __attribute__((address_space(3))) bf16x8*)(kp+2048); kf[3]=*(const __attribute__((address_space(3))) bf16x8*)(kp+2560);
  kf[4]=*(const __attribute__((address_space(3))) bf16x8*)(kp+4096); kf[5]=*(const __attribute__((address_space(3))) bf16x8*)(kp+4608);
  kf[6]=*(const __attribute__((address_space(3))) bf16x8*)(kp+6144); kf[7]=*(const __attribute__((address_space(3))) bf16x8*)(kp+6656);
}
__device__ __forceinline__ void kload2(bf16x8*kf,lds_cptr kp,int j){ kf[2*j]=*(const __attribute__((address_space(3))) bf16x8*)(kp+j*2048); kf[2*j+1]=*(const __attribute__((address_space(3))) bf16x8*)(kp+j*2048+512); }
__device__ __forceinline__ s16x4 vtr(lds_cptr p){ return __builtin_bit_cast(s16x4,__builtin_amdgcn_ds_read_tr16_b64_v4i16((__attribute__((address_space(3))) v4i16_t*)p)); }
__device__ __forceinline__ float rowmax(const f32x16&p0,const f32x16&p1){
  float a=max3f(p0[0],p0[1],p1[0]),b=max3f(p0[2],p0[3],p1[1]);a=max3f(a,p1[2],p1[3]);
  #pragma unroll
  for(int r=4;r<16;r+=4){a=max3f(a,p0[r],p0[r+1]);b=max3f(b,p0[r+2],p0[r+3]);a=max3f(a,p1[r],p1[r+1]);b=max3f(b,p1[r+2],p1[r+3]);}
  const float m=max2f(a,b);
  auto rr=__builtin_amdgcn_permlane32_swap(__float_as_uint(m),__float_as_uint(m),false,false);
  return max2f(__uint_as_float(rr[0]),__uint_as_float(rr[1]));
}
__device__ __forceinline__ void pv(f32x16*o,int vb,bf16x8 pa0,bf16x8 pa1,bf16x8 pa2,bf16x8 pa3){
  #pragma unroll
  for(int d0=0;d0<2;++d0){s16x4 lo[4],hi[4];
    #pragma unroll
    for(int ks=0;ks<4;++ks){
      asm volatile("ds_read_b64_tr_b16 %0,%1 offset:%c2":"=&v"(lo[ks]):"v"(vb),"i"(d0*4096+ks*1024):"memory");
      asm volatile("ds_read_b64_tr_b16 %0,%1 offset:%c2":"=&v"(hi[ks]):"v"(vb),"i"(d0*4096+ks*1024+512):"memory");}
    asm volatile("s_waitcnt lgkmcnt(0)":::"memory");SBAR();
    #define PK(k) (bf16x8){lo[k][0],lo[k][1],lo[k][2],lo[k][3],hi[k][0],hi[k][1],hi[k][2],hi[k][3]}
    o[d0]=__builtin_amdgcn_mfma_f32_32x32x16_bf16(pa0,PK(0),o[d0],0,0,0);
    o[d0]=__builtin_amdgcn_mfma_f32_32x32x16_bf16(pa1,PK(1),o[d0],0,0,0);
    o[d0]=__builtin_amdgcn_mfma_f32_32x32x16_bf16(pa2,PK(2),o[d0],0,0,0);
    o[d0]=__builtin_amdgcn_mfma_f32_32x32x16_bf16(pa3,PK(3),o[d0],0,0,0);
    #undef PK
  }
}

#ifndef ATTN_STORE16
#define ATTN_STORE16(p,v) (*(u32x4*)(p)=(v))
#endif
template<int THRL> __device__ __forceinline__ void attn_unit(long rowbase,int S,int h,int qb,const bf16*__restrict__ Z,bf16*O,char*shm){
  int tid_=threadIdx.x; asm volatile("":"+v"(tid_)); const int tid=tid_,lane=tid&63,r32=lane&31,hi=lane>>5; const int wid=__builtin_amdgcn_readfirstlane(tid>>6);
  const int q0=qb*QB;
  const bf16*Qw=Z+(rowbase+q0+wid*QBLK)*ZP+h*D;
  const bf16*Kh=Z+rowbase*ZP+512+(h>>2)*D,*Vh=Z+rowbase*ZP+640+(h>>2)*D;
  const unsigned lds0=(unsigned)(uintptr_t)shm;
  float*wsf=(float*)(shm+LDS_WS)+wid*64;
  const bf16*ksrc=Kh+(long)lane*ZP+wid*8;
  const bf16*vsrc=Vh+(long)(16*(wid&3)+(lane>>2))*ZP+(wid>>2)*32+(lane&3)*8;
  const unsigned kdst=lds0+LDS_K+wid*1024, vdst=lds0+LDS_V+wid*1024;
  #define DMA_K(t,slot) glds16(ksrc+(long)(t)*KVBLK*ZP,(unsigned)__builtin_amdgcn_readfirstlane(kdst+(slot)))
  #define DMA_V(t,slot) glds16(vsrc+(long)(t)*KVBLK*ZP,(unsigned)__builtin_amdgcn_readfirstlane(vdst+(slot)))
  const int vb0=(int)(lds0+LDS_V)+((lane>>4)&1)*32+(lane&3)*8+(4*hi+((lane&15)>>2))*64;
  const char*Kbase=shm+LDS_K; bf16x8 kf[8];
  const lds_cptr shm3=(lds_cptr)shm; const lds_cptr kp0=shm3+LDS_K+hi*1024+r32*16; const lds_cptr vp0=shm3+LDS_V+((lane>>4)&1)*32+(lane&3)*8+(4*hi+((lane&15)>>2))*64;
  const int NT=S/KVBLK;
  DMA_K(0,0);DMA_V(0,0);DMA_K(1,SLOTB);
  bf16x8 qr[4];
  #pragma unroll
  for(int d0=0;d0<4;++d0)qr[d0]=*reinterpret_cast<const bf16x8*>(&Qw[(long)r32*ZP+d0*16+hi*8]);
  float mhat=0.f,l_reg=0.f;f32x16 o[2];o[0]=f32x16{};o[1]=f32x16{};f32x16 negm=f32x16{};asm volatile("":"+v"(negm));
  const int qrel=wid*QBLK+r32;
  #define CMASK(P0,P1,t) do{}while(0)
  bool resc=false;
  #define START(P0,P1) do{ const float rm=rowmax(P0,P1); resc=false; \
    { const float dl=rm; mhat=fadd_s(mhat,dl); \
      _Pragma("unroll") for(int r=0;r<16;++r){P0[r]=fsub_s(P0[r],dl);P1[r]=fsub_s(P1[r],dl);} \
      _Pragma("unroll") for(int r=0;r<16;++r)negm[r]=-mhat; asm volatile("":"+v"(negm)); } \
    _Pragma("unroll") for(int r=0;r<16;++r)P0[r]=__builtin_amdgcn_exp2f(P0[r]); }while(0)
  #define RESC() do{ if(resc){ asm volatile("s_waitcnt lgkmcnt(0)":::"memory"); \
      _Pragma("unroll") for(int d_=0;d_<2;++d_) _Pragma("unroll") for(int r=0;r<16;++r)o[d_][r]*=wsf[crow(r,hi)]; } }while(0)
  f32x16 pA0,pA1,pB0,pB1;
  int sl_prev=0,sl_cur=0,sl_next=SLOTB;
  #define ROT() do{sl_prev=sl_cur;sl_cur=sl_next;sl_next=(sl_next==(NSLOT-1)*SLOTB)?0:sl_next+SLOTB;}while(0)
  DMA_K(2,2*SLOTB);
  WAIT_BAR(3);
  qkt(pA0,pA1,Kbase,qr,negm,r32,hi);asm volatile("s_nop 15\n\ts_nop 7":"+v"(pA0),"+v"(pA1));CMASK(pA0,pA1,0);
  START(pA0,pA1);
  _Pragma("unroll") for(int r=0;r<16;++r)pA1[r]=__builtin_amdgcn_exp2f(pA1[r]);
  WAIT_BAR(0);
  DMA_K(3,0);DMA_V(1,SLOTB);
  ROT();
  kload8(kf,kp0+sl_cur);
  WAIT_BAR(2);
  s16x4 vlo[8],vhi[8]; u32x4 pw0,pw1,pw2,pw3;
  #define PKW(P,B) cvtpk_s(P[B],P[B+1])
  #define PAF(k) __builtin_bit_cast(bf16x8,pw##k)
  #define VFR(i) (bf16x8){vlo[i][0],vlo[i][1],vlo[i][2],vlo[i][3],vhi[i][0],vhi[i][1],vhi[i][2],vhi[i][3]}
  #define PIN(x) asm volatile("":"+v"(x))
  #define MX3(a,b,c) __builtin_fmaxf(__builtin_fmaxf((a),(b)),(c))
  #define GAPA(MF,A0,A1,A2,A3,W0,W1,PW) do{ MF; sacc+=A0; sacc+=A1; sacc+=A2; sacc+=A3; PIN(sacc); W0; W1; PIN(PW); SBAR(); }while(0)
  #define EX(v) __builtin_amdgcn_exp2f(v)
  #define GAPB(MF,X,B) do{ MF; X[B]=EX(X[B]); X[B+1]=EX(X[B+1]); X[B+2]=EX(X[B+2]); X[B+3]=EX(X[B+3]); PIN(X); SBAR(); }while(0)
  #define VRD(i) do{ vlo[i]=vtr(vp_+(((i)>>2)*4096+((i)&3)*1024)); vhi[i]=vtr(vp_+(((i)>>2)*4096+((i)&3)*1024+512)); }while(0)
  #define KRD(G,j) do{ if(G){ kload2(kf,kp0+sl_next,j); SBAR(); } }while(0)
  #define STEP(C0,C1,P0,P1,t,GK,GV,GL) do{ SBAR(); \
    const lds_cptr vp_=vp0+sl_prev; \
    VRD(0); SBAR(); float sacc=(P0[0]+P0[1]); \
    GAPA(C0=__builtin_amdgcn_mfma_f32_32x32x16_bf16(kf[0],qr[0],negm,0,0,0), P0[2],P0[3],P0[4],P0[5],     pw0[0]=PKW(P0,0), pw0[1]=PKW(P0,2), pw0); \
    VRD(4); SBAR(); GAPA(C1=__builtin_amdgcn_mfma_f32_32x32x16_bf16(kf[1],qr[0],negm,0,0,0), P0[6],P0[7],P0[8],P0[9],     pw0[2]=PKW(P0,4), pw0[3]=PKW(P0,6), pw0); \
    VRD(1); SBAR(); GAPA(C0=__builtin_amdgcn_mfma_f32_32x32x16_bf16(kf[2],qr[1],C0,0,0,0),   P0[10],P0[11],P0[12],P0[13], pw1[0]=PKW(P0,8), pw1[1]=PKW(P0,10), pw1); \
    VRD(5); SBAR(); GAPA(C1=__builtin_amdgcn_mfma_f32_32x32x16_bf16(kf[3],qr[1],C1,0,0,0),   P0[14],P0[15],P1[0],P1[1],   pw1[2]=PKW(P0,12),pw1[3]=PKW(P0,14), pw1); \
    VRD(2); SBAR(); GAPA(C0=__builtin_amdgcn_mfma_f32_32x32x16_bf16(kf[4],qr[2],C0,0,0,0),   P1[2],P1[3],P1[4],P1[5],     pw2[0]=PKW(P1,0), pw2[1]=PKW(P1,2), pw2); \
    VRD(6); SBAR(); GAPA(C1=__builtin_amdgcn_mfma_f32_32x32x16_bf16(kf[5],qr[2],C1,0,0,0),   P1[6],P1[7],P1[8],P1[9],     pw2[2]=PKW(P1,4), pw2[3]=PKW(P1,6), pw2); \
    VRD(3); SBAR(); GAPA(C0=__builtin_amdgcn_mfma_f32_32x32x16_bf16(kf[6],qr[3],C0,0,0,0),   P1[10],P1[11],P1[12],P1[13], pw3[0]=PKW(P1,8), pw3[1]=PKW(P1,10), pw3); \
    VRD(7); SBAR(); GAPA(C1=__builtin_amdgcn_mfma_f32_32x32x16_bf16(kf[7],qr[3],C1,0,0,0),   P1[14],P1[15],0.f,0.f,       pw3[2]=PKW(P1,12),pw3[3]=PKW(P1,14), pw3); \
    l_reg+=sacc; \
    if(GK){DMA_K((t)+3,sl_cur);} if(GV){DMA_V((t)+1,sl_next);} \
    CMASK(C0,C1,t); \
    { float a=MX3(C0[0],C0[1],C1[0]),b=MX3(C0[2],C0[3],C1[1]); a=MX3(a,C1[2],C1[3]); \
      _Pragma("unroll") for(int r=4;r<16;r+=4){a=MX3(a,C0[r],C0[r+1]);b=MX3(b,C0[r+2],C0[r+3]);a=MX3(a,C1[r],C1[r+1]);b=MX3(b,C1[r+2],C1[r+3]);} \
      float rm=__builtin_fmaxf(a,b); { auto rr=__builtin_amdgcn_permlane32_swap(__float_as_uint(rm),__float_as_uint(rm),false,false); rm=__builtin_fmaxf(__uint_as_float(rr[0]),__uint_as_float(rr[1])); } \
      resc=false; \
      if(__builtin_expect(__any(rm>(float)THRL),0)){ const float dl=__builtin_fmaxf(rm,0.f); mhat+=dl; \
        _Pragma("unroll") for(int r=0;r<16;++r){C0[r]-=dl;C1[r]-=dl;} \
        _Pragma("unroll") for(int r=0;r<16;++r)negm[r]=-mhat; asm volatile("":"+v"(negm)); \
        const float f=__builtin_amdgcn_exp2f(-dl); l_reg*=f; if(hi==0)wsf[r32]=f; resc=true; } } \
    SBAR(); \
    GAPB(o[0]=__builtin_amdgcn_mfma_f32_32x32x16_bf16(PAF(0),VFR(0),o[0],0,0,0), C0,0); \
    GAPB(o[1]=__builtin_amdgcn_mfma_f32_32x32x16_bf16(PAF(0),VFR(4),o[1],0,0,0), C0,4); \
    KRD(GL,0); GAPB(o[0]=__builtin_amdgcn_mfma_f32_32x32x16_bf16(PAF(1),VFR(1),o[0],0,0,0), C0,8); \
    KRD(GL,1); GAPB(o[1]=__builtin_amdgcn_mfma_f32_32x32x16_bf16(PAF(1),VFR(5),o[1],0,0,0), C0,12); \
    KRD(GL,2); GAPB(o[0]=__builtin_amdgcn_mfma_f32_32x32x16_bf16(PAF(2),VFR(2),o[0],0,0,0), C1,0); \
    KRD(GL,3); GAPB(o[1]=__builtin_amdgcn_mfma_f32_32x32x16_bf16(PAF(2),VFR(6),o[1],0,0,0), C1,4); \
    GAPB(o[0]=__builtin_amdgcn_mfma_f32_32x32x16_bf16(PAF(3),VFR(3),o[0],0,0,0), C1,8); \
    GAPB(o[1]=__builtin_amdgcn_mfma_f32_32x32x16_bf16(PAF(3),VFR(7),o[1],0,0,0), C1,12); \
    }while(0)
  int t=1;
  #undef CMASK
  #define CMASK(P0,P1,t) do{}while(0)
  for(;t+5<NT;t+=2){
    STEP(pB0,pB1,pA0,pA1,t,true,true,true);     WAIT_BAR(2); RESC(); ROT();
    STEP(pA0,pA1,pB0,pB1,t+1,true,true,true);   WAIT_BAR(2); RESC(); ROT();
  }
  #undef CMASK
  #define CMASK(P0,P1,t) do{}while(0)
  #define ENDW(tt) do{ if((tt)+3<NT){WAIT_BAR(2);} else if((tt)+2<NT){WAIT_BAR(1);} else {WAIT_BAR(0);} }while(0)
  for(;t+1<NT;t+=2){
    STEP(pB0,pB1,pA0,pA1,t,(t+3<NT),(t+1<NT),(t+1<NT));       ENDW(t);   RESC(); ROT();
    STEP(pA0,pA1,pB0,pB1,t+1,(t+4<NT),(t+2<NT),(t+2<NT));     ENDW(t+1); RESC(); ROT();
  }
  STEP(pB0,pB1,pA0,pA1,NT-1,false,false,false); RESC();
  { float sacc=pB0[0]+pB0[1]; _Pragma("unroll") for(int r=2;r<16;++r)sacc+=pB0[r]; _Pragma("unroll") for(int r=0;r<16;++r)sacc+=pB1[r]; l_reg+=sacc;
    pw0=(u32x4){PKW(pB0,0),PKW(pB0,2),PKW(pB0,4),PKW(pB0,6)};pw1=(u32x4){PKW(pB0,8),PKW(pB0,10),PKW(pB0,12),PKW(pB0,14)};pw2=(u32x4){PKW(pB1,0),PKW(pB1,2),PKW(pB1,4),PKW(pB1,6)};pw3=(u32x4){PKW(pB1,8),PKW(pB1,10),PKW(pB1,12),PKW(pB1,14)};
    SBAR(); pv(o,vb0+sl_cur,PAF(0),PAF(1),PAF(2),PAF(3)); }
  #undef PKW
  #undef PAF
  #undef VFR
  #undef PIN
  #undef MX3
  #undef GAPA
  #undef GAPB
  #undef EX
  #undef VRD
  #undef KRD
  #undef STEP
  #undef ENDW
  {auto rr=__builtin_amdgcn_permlane32_swap(__float_as_uint(l_reg),__float_as_uint(l_reg),false,false);l_reg=__uint_as_float(rr[0])+__uint_as_float(rr[1]);}
  if(hi==0)wsf[32+r32]=l_reg;asm volatile("s_waitcnt lgkmcnt(0)":::"memory");
  float rli[16];
  #pragma unroll
  for(int r=0;r<16;++r)rli[r]=__builtin_amdgcn_rcpf(wsf[32+crow(r,hi)]);
  bf16*Ow=O+(rowbase+q0+wid*QBLK)*OP+h*D;
  { bf16*stg=(bf16*)(shm+LDS_OST)+wid*2048;
    #pragma unroll
    for(int r=0;r<16;++r){const int orow=crow(r,hi);
      #pragma unroll
      for(int d0=0;d0<2;++d0)stg[orow*64+d0*32+r32]=__float2bfloat16(o[d0][r]*rli[r]);}
    asm volatile("s_waitcnt lgkmcnt(0)":::"memory");
    #pragma unroll
    for(int i=0;i<4;++i){const int row=i*8+(lane>>3),ch=lane&7; const u32x4 v=*(const u32x4*)(stg+row*64+ch*8); ATTN_STORE16(Ow+(long)row*OP+ch*8,v);} }
  asm volatile("s_waitcnt lgkmcnt(0)\n\ts_barrier":::"memory");
  #undef DMA_K
  #undef DMA_V
  #undef CMASK
  #undef START
  #undef RESC
  #undef ROT
}
constexpr int ATTN_LDS_BYTES=LDS_BYTES;
#undef SBAR
#undef WAIT_BAR
}

constexpr int NWAVES = 8;
constexpr int M = 32768, MP = 16384, DMODEL = 1024, DIN = 2304, DFF = 2816, NUP = 5632, PLE = 256, SP = 4096, SS = 2048;
constexpr float EPS = 1e-6f;
constexpr size_t MiB = 1u << 20;
constexpr size_t WS_ROPE = 0;
constexpr size_t WS_WIN = 1 * MiB;
constexpr size_t WS_WOUT = WS_WIN + (size_t)DIN * DMODEL * 2;
constexpr size_t WS_WUP = WS_WOUT + (size_t)DMODEL * DMODEL * 2;
constexpr size_t WS_WDOWN = WS_WUP + (size_t)NUP * DMODEL * 2;
constexpr size_t WS_WGATE = WS_WDOWN + (size_t)DMODEL * DFF * 2;
constexpr size_t WS_WPROJ = WS_WGATE + (size_t)DMODEL * DMODEL * 2;
constexpr size_t WS_A = 28 * MiB;
constexpr size_t WS_BIG = 92 * MiB;
constexpr size_t WS_E = 268 * MiB;
constexpr size_t WS_P16 = 274 * MiB;
constexpr size_t WS_END = 290 * MiB;
static_assert(WS_WPROJ + (size_t)DMODEL * PLE * 2 <= WS_A, "weights fit");
constexpr int RING_BYTES = 131072, HALO_OFF = RING_BYTES + 1024, LDS_BYTES = 147456;

typedef unsigned short bf16;
typedef unsigned v4u __attribute__((ext_vector_type(4)));
typedef unsigned v2u __attribute__((ext_vector_type(2)));
typedef float f32x4 __attribute__((ext_vector_type(4)));
#define LAS __attribute__((address_space(3)))
__device__ __forceinline__ unsigned pk2(float lo, float hi) { return pg8::cvt_pk_bf16(lo, hi); }
__device__ __forceinline__ float bflo(unsigned w) { return __uint_as_float(w << 16); }
__device__ __forceinline__ float bfhi(unsigned w) { return __uint_as_float(w & 0xffff0000u); }
__device__ __forceinline__ void unpack8(const v4u v, float* f) { f[0] = bflo(v.x); f[1] = bfhi(v.x); f[2] = bflo(v.y); f[3] = bfhi(v.y); f[4] = bflo(v.z); f[5] = bfhi(v.z); f[6] = bflo(v.w); f[7] = bfhi(v.w); }
__device__ __forceinline__ v4u pack8(const float* f) { v4u o; o.x = pk2(f[0], f[1]); o.y = pk2(f[2], f[3]); o.z = pk2(f[4], f[5]); o.w = pk2(f[6], f[7]); return o; }
__device__ __forceinline__ float wave_sum(float v) {
#pragma unroll
    for (int o = 1; o < 64; o <<= 1) v += __shfl_xor(v, o);
    return v;
}
struct Args { void* p[20]; };

__device__ __forceinline__ void transpose_item(const float* W, int K, int N, bf16* WT, int mode, float* scr, int item, int lane) {
    const int nblk = N / 32, kb = item / nblk, nb = item % nblk, k0 = 64 * kb, n0 = 32 * nb;
#pragma unroll 8
    for (int i = 0; i < 32; ++i) { const int kk = 2 * i + (lane >> 5); scr[kk * 33 + (lane & 31)] = W[(size_t)(k0 + kk) * N + n0 + (lane & 31)]; }
    __builtin_amdgcn_s_waitcnt(0xc07f); asm volatile("" ::: "memory");
    int r0 = n0;
    if (mode == 1) { r0 = (n0 < DFF) ? 256 * (n0 / 128) + n0 % 128 : 256 * ((n0 - DFF) / 128) + 128 + (n0 - DFF) % 128; }
    const int c = lane & 7;
#pragma unroll
    for (int j = 0; j < 4; ++j) { const int n = (lane >> 3) + 8 * j; const float* s = scr + (8 * c) * 33 + n;
        v4u o; o.x = pk2(s[0 * 33], s[1 * 33]); o.y = pk2(s[2 * 33], s[3 * 33]); o.z = pk2(s[4 * 33], s[5 * 33]); o.w = pk2(s[6 * 33], s[7 * 33]);
        *(v4u*)(WT + (size_t)(r0 + n) * K + k0 + 8 * c) = o; }
    __builtin_amdgcn_s_waitcnt(0xc07f); asm volatile("" ::: "memory");
}
__device__ __forceinline__ void rms_row_to_bf16(const float* xrow, const float* g, bf16* orow, int lane) {
    const f32x4* xr = (const f32x4*)xrow + lane; const f32x4* gr = (const f32x4*)g + lane;
    f32x4 v[4]; float s = 0.f;
#pragma unroll
    for (int j = 0; j < 4; ++j) { v[j] = xr[64 * j]; s += (v[j].x * v[j].x + v[j].y * v[j].y) + (v[j].z * v[j].z + v[j].w * v[j].w); }
    const float rstd = rsqrtf(wave_sum(s) * (1.f / DMODEL) + EPS);
    v2u* o8 = (v2u*)orow + lane;
#pragma unroll
    for (int j = 0; j < 4; ++j) { const f32x4 gg = gr[64 * j]; v2u o; o.x = pk2(v[j].x * rstd * gg.x, v[j].y * rstd * gg.y); o.y = pk2(v[j].z * rstd * gg.z, v[j].w * rstd * gg.w); o8[64 * j] = o; }
}
__device__ __forceinline__ const float* hin_row(const float* xp, const float* xs, const float* out, int l, int m) {
    return l == 0 ? (m < MP ? xp + (size_t)m * DMODEL : xs + (size_t)(m - MP) * DMODEL) : out + (size_t)m * DMODEL;
}
constexpr float ATT_C2 = 0.125f * 1.4426950408889634f;
__device__ __forceinline__ void mixprep_row(int row, bf16* Z, bf16* MIX, const float* qg, const float* kg, const float* cw, const float* cog, const float* rope, int lane) {
    const int S = row < MP ? SP : SS, t = row & (S - 1);
    bf16* zr = Z + (size_t)row * DIN;
    const int c = lane & 7;
    const int pos = (c >> 2) ? (t & 63) : (t >> 6);
    float cs[8], sn[8];
    { const f32x4* rp = (const f32x4*)(rope + (size_t)(pos * 16 + (c & 1) * 8) * 2);
#pragma unroll
      for (int j = 0; j < 4; ++j) { const f32x4 r = rp[j]; cs[2 * j] = r.x; sn[2 * j] = r.y; cs[2 * j + 1] = r.z; sn[2 * j + 1] = r.w; } }
    const float sgn = (c & 2) ? 1.f : -1.f;
#pragma unroll
    for (int part = 0; part < 2; ++part) {
        bf16* p = part == 0 ? zr + lane * 8 : zr + 512 + (lane & 15) * 8;
        const float* g = (part == 0 ? qg : kg) + c * 8;
        const float sc = part == 0 ? ATT_C2 : 1.f;
        float v[8]; unpack8(*(const v4u*)p, v);
        float ss = 0.f;
#pragma unroll
        for (int j = 0; j < 8; ++j) ss += v[j] * v[j];
        ss += __shfl_xor(ss, 1); ss += __shfl_xor(ss, 2); ss += __shfl_xor(ss, 4);
        const float rstd = rsqrtf(ss * (1.f / 64.f) + EPS);
        float o[8];
#pragma unroll
        for (int j = 0; j < 8; ++j) v[j] = v[j] * rstd * g[j];
#pragma unroll
        for (int j = 0; j < 8; ++j) { const float pr = __shfl_xor(v[j], 2); o[j] = (v[j] * cs[j] + sgn * pr * sn[j]) * sc; }
        if (part == 0 || lane < 16) *(v4u*)p = pack8(o);
    }
    {
        const int ch = lane * 8;
        float gb[8], a[8], b[8], acc[8];
        unpack8(*(const v4u*)(zr + 768 + ch), gb);
        unpack8(*(const v4u*)(zr + 1280 + ch), a); unpack8(*(const v4u*)(zr + 1792 + ch), b);
        const float* w0 = cw + ch; const float* w1 = cw + 512 + ch; const float* w2 = cw + 1024 + ch;
#pragma unroll
        for (int j = 0; j < 8; ++j) acc[j] = w1[j] * a[j] * b[j];
        if (t > 0) { unpack8(*(const v4u*)(zr - DIN + 1280 + ch), a); unpack8(*(const v4u*)(zr - DIN + 1792 + ch), b);
#pragma unroll
            for (int j = 0; j < 8; ++j) acc[j] += w0[j] * a[j] * b[j]; }
        if (t < S - 1) { unpack8(*(const v4u*)(zr + DIN + 1280 + ch), a); unpack8(*(const v4u*)(zr + DIN + 1792 + ch), b);
#pragma unroll
            for (int j = 0; j < 8; ++j) acc[j] += w2[j] * a[j] * b[j]; }
        float ss = 0.f;
#pragma unroll
        for (int j = 0; j < 8; ++j) { acc[j] *= gb[j]; ss += acc[j] * acc[j]; }
        const float rstd = rsqrtf(wave_sum(ss) * (1.f / 512.f) + EPS);
#pragma unroll
        for (int j = 0; j < 8; ++j) acc[j] = acc[j] * rstd * cog[ch + j];
        *(v4u*)(MIX + (size_t)row * DMODEL + 512 + ch) = pack8(acc);
    }
}
__device__ __forceinline__ void onorm_row(int row, bf16* MIX, const float* g, int lane) {
    bf16* p = MIX + (size_t)row * DMODEL + lane * 8;
    float v[8]; unpack8(*(const v4u*)p, v); float ss = 0.f;
#pragma unroll
    for (int j = 0; j < 8; ++j) ss += v[j] * v[j];
    const float rstd = rsqrtf(wave_sum(ss) * (1.f / 512.f) + EPS);
#pragma unroll
    for (int j = 0; j < 8; ++j) v[j] = v[j] * rstd * g[lane * 8 + j];
    *(v4u*)p = pack8(v);
}
__device__ __forceinline__ float silu_mul(float g, float u) { return g * __builtin_amdgcn_rcpf(1.f + __builtin_amdgcn_exp2f(-1.4426950408889634f * g)) * u; }

__global__ void __launch_bounds__(NWAVES * 64, 2) mega_fwd(Args a) {
    extern __shared__ __attribute__((aligned(16))) unsigned char lds[];
    cg::grid_group grid = cg::this_grid();
#define PH_BEGIN \
    int tid_ = threadIdx.x; asm volatile("" : "+v"(tid_)); int zi = 0; asm volatile("" : "+s"(zi)); \
    const int tid = tid_, lane = tid & 63, wave = __builtin_amdgcn_readfirstlane(tid >> 6); \
    const int G = gridDim.x + zi, bx = blockIdx.x + zi; \
    const int vcu = (G % 8 == 0) ? (bx % 8) * (G / 8) + bx / 8 : bx; \
    const int gw = vcu * NWAVES + wave, NGW = G * NWAVES; \
    unsigned char* ws = (unsigned char*)a.p[19 + zi]; float* outp = (float*)a.p[18 + zi]; \
    float* rope = (float*)(ws + WS_ROPE); \
    bf16* Win = (bf16*)(ws + WS_WIN); bf16* Wout = (bf16*)(ws + WS_WOUT); bf16* Wup = (bf16*)(ws + WS_WUP); bf16* Wdown = (bf16*)(ws + WS_WDOWN); \
    bf16* Wgate = (bf16*)(ws + WS_WGATE); bf16* Wproj = (bf16*)(ws + WS_WPROJ); \
    bf16* A = (bf16*)(ws + WS_A); bf16* BIG = (bf16*)(ws + WS_BIG); bf16* EB = (bf16*)(ws + WS_E); bf16* P16 = (bf16*)(ws + WS_P16); \
    LAS unsigned char* ldsl = (LAS unsigned char*)lds; \
    (void)tid; (void)lane; (void)wave; (void)vcu; (void)gw; (void)NGW; (void)rope; (void)Win; (void)Wout; (void)Wup; (void)Wdown; (void)Wgate; (void)Wproj; (void)A; (void)BIG; (void)EB; (void)P16; (void)ldsl; (void)outp;
#define IN(k) ((const float*)a.p[(k) + zi])
#pragma unroll 1
    for (int l = 0; l < 2; ++l) {
#ifndef SKIP_P0
        { PH_BEGIN
            float* scr = (float*)(lds + wave * 16384);
            constexpr int I_IN = (DMODEL / 64) * (DIN / 32), I_OUT = (DMODEL / 64) * (DMODEL / 32), I_UP = (DMODEL / 64) * (NUP / 32), I_DOWN = (DFF / 64) * (DMODEL / 32), I_GATE = I_OUT, I_PROJ = (PLE / 64) * (DMODEL / 32);
            constexpr int NITEMS = I_IN + I_OUT + I_UP + I_DOWN + I_GATE + I_PROJ;
            for (int it = gw; it < NITEMS; it += NGW) {
                int r = it;
                if (r < I_IN) { transpose_item(IN(5) + (size_t)l * DMODEL * DIN, DMODEL, DIN, Win, 0, scr, r, lane); continue; } r -= I_IN;
                if (r < I_OUT) { transpose_item(IN(11) + (size_t)l * DMODEL * DMODEL, DMODEL, DMODEL, Wout, 0, scr, r, lane); continue; } r -= I_OUT;
                if (r < I_UP) { transpose_item(IN(13) + (size_t)l * DMODEL * NUP, DMODEL, NUP, Wup, 1, scr, r, lane); continue; } r -= I_UP;
                if (r < I_DOWN) { transpose_item(IN(15) + (size_t)l * DFF * DMODEL, DFF, DMODEL, Wdown, 0, scr, r, lane); continue; } r -= I_DOWN;
                if (r < I_GATE) { transpose_item(IN(16) + (size_t)l * DMODEL * DMODEL, DMODEL, DMODEL, Wgate, 0, scr, r, lane); continue; } r -= I_GATE;
                transpose_item(IN(17) + (size_t)l * PLE * DMODEL, PLE, DMODEL, Wproj, 0, scr, r, lane);
            }
            const float* ga = IN(4) + l * DMODEL; const float* xp = IN(0); const float* xs = IN(1); const float* pp_ = IN(2); const float* ps_ = IN(3);
            for (int m = gw; m < M; m += NGW) {
                rms_row_to_bf16(hin_row(xp, xs, outp, l, m), ga, A + (size_t)m * DMODEL, lane);
                const float* pr = (m < MP ? pp_ + ((size_t)l * MP + m) * PLE : ps_ + ((size_t)l * MP + (m - MP)) * PLE);
                const f32x4 pv = ((const f32x4*)pr)[lane]; v2u o; o.x = pk2(pv.x, pv.y); o.y = pk2(pv.z, pv.w); ((v2u*)(P16 + (size_t)m * PLE))[lane] = o;
            }
            if (l == 0) { const int gt = bx * (NWAVES * 64) + tid;
                if (gt < 1024) { const int pos = gt >> 4, j = gt & 15; const float fr = __builtin_amdgcn_exp2f(-(float)j * 0.8304820237218406f); const float ang = (float)pos * fr;
                    const float rev = ang * 0.15915494309189535f; rope[2 * gt] = __builtin_amdgcn_cosf(rev); rope[2 * gt + 1] = __builtin_amdgcn_sinf(rev); } }
        }
#endif
        grid.sync();
#ifndef SKIP_P1
        { PH_BEGIN
            pg8::Gemm g{A, Win, M, DIN, DMODEL}; pg8::StaticOrder S; S.init(M, DIN, G, bx);
            pg8::EpiStoreBf16 E{BIG, DIN};
            pg8::gemm_phase<pg8::EpiStoreBf16, pg8::StaticOrder, true, true>(ldsl, g, S, E);
        }
#endif
        grid.sync();
#ifndef SKIP_P2
        { PH_BEGIN
            const float* qg = IN(6) + l * 64; const float* kg = IN(7) + l * 64; const float* cw = IN(8) + l * 3 * 512; const float* cog = IN(10) + l * 512;
            for (int m = gw; m < M; m += NGW) mixprep_row(m, BIG, A, qg, kg, cw, cog, rope, lane);
        }
#endif
        grid.sync();
#ifndef SKIP_P3
        { PH_BEGIN
            const int u0 = (int)(((long)vcu * 512) / G), u1 = (int)(((long)(vcu + 1) * 512) / G);
            for (int u = u0; u < u1; ++u) { const int bh = u >> 4, qb = u & 15; attn_body::attn_unit<8>((long)(bh >> 3) * SP, SP, bh & 7, qb, (const attn_body::bf16*)BIG, (attn_body::bf16*)A, (char*)lds); }
            for (int u = u0; u < u1; ++u) { const int bh = u >> 3, qb = u & 7; attn_body::attn_unit<8>((long)MP + (long)(bh >> 3) * SS, SS, bh & 7, qb, (const attn_body::bf16*)BIG, (attn_body::bf16*)A, (char*)lds); }
        }
#endif
        grid.sync();
#ifndef SKIP_P4
        { PH_BEGIN
            const float* aog = IN(9) + l * 512;
            for (int m = gw; m < M; m += NGW) onorm_row(m, A, aog, lane);
        }
#endif
        grid.sync();
#ifndef SKIP_P5
        { PH_BEGIN
            pg8::Gemm g{A, Wout, M, DMODEL, DMODEL}; pg8::StaticOrder S; S.init(M, DMODEL, G, bx);
            pg8::EpiResF32<false> E{l == 0 ? IN(0) : outp, l == 0 ? IN(1) - (size_t)MP * DMODEL : outp, outp, nullptr};
            pg8::gemm_phase<pg8::EpiResF32<false>, pg8::StaticOrder, true, true>(ldsl, g, S, E);
        }
#endif
        grid.sync();
#ifndef SKIP_P6
        { PH_BEGIN
            const float* gf = IN(12) + l * DMODEL;
            for (int m = gw; m < M; m += NGW) rms_row_to_bf16(outp + (size_t)m * DMODEL, gf, A + (size_t)m * DMODEL, lane);
        }
#endif
        grid.sync();
#ifndef SKIP_P7
        { PH_BEGIN
            pg8::Gemm g{A, Wup, M, NUP, DMODEL}; pg8::StaticOrder S; S.init(M, NUP, G, bx);
            pg8::EpiConvAct E{BIG, EB, IN(14) + (size_t)l * 3 * NUP, (LAS float*)(ldsl + HALO_OFF)};
            pg8::gemm_phase<pg8::EpiConvAct, pg8::StaticOrder, true, true>(ldsl, g, S, E);
        }
#endif
        grid.sync();
#ifndef SKIP_P8
        { PH_BEGIN
            const float* cw = IN(14) + (size_t)l * 3 * NUP;
            for (int idx = bx * (NWAVES * 64) + tid; idx < 127 * 704; idx += G * NWAVES * 64) {
                const int pm = 1 + idx / 704, ch = (idx % 704) * 4;
                const bool seq_start = pm < 64 ? (pm % 16 == 0) : ((pm - 64) % 8 == 0);
                if (seq_start) continue;
                const bf16* ea = EB + (size_t)((pm - 1) * 4 + 2) * NUP; const bf16* eb = ea + NUP; const bf16* ec = EB + (size_t)(pm * 4) * NUP; const bf16* ed = ec + NUP;
                float fa[2][4], fb[2][4], fc[2][4], fd[2][4]; f32x4 w[2][3];
#pragma unroll
                for (int bj = 0; bj < 2; ++bj) {
                    v2u x;
                    x = *(const v2u*)(ea + bj * DFF + ch); fa[bj][0] = bflo(x.x); fa[bj][1] = bfhi(x.x); fa[bj][2] = bflo(x.y); fa[bj][3] = bfhi(x.y);
                    x = *(const v2u*)(eb + bj * DFF + ch); fb[bj][0] = bflo(x.x); fb[bj][1] = bfhi(x.x); fb[bj][2] = bflo(x.y); fb[bj][3] = bfhi(x.y);
                    x = *(const v2u*)(ec + bj * DFF + ch); fc[bj][0] = bflo(x.x); fc[bj][1] = bfhi(x.x); fc[bj][2] = bflo(x.y); fc[bj][3] = bfhi(x.y);
                    x = *(const v2u*)(ed + bj * DFF + ch); fd[bj][0] = bflo(x.x); fd[bj][1] = bfhi(x.x); fd[bj][2] = bflo(x.y); fd[bj][3] = bfhi(x.y);
#pragma unroll
                    for (int j = 0; j < 3; ++j) w[bj][j] = *(const f32x4*)(cw + j * NUP + bj * DFF + ch);
                }
                float oa[4], ob[4];
#pragma unroll
                for (int i = 0; i < 4; ++i) {
                    const float gA = w[0][0][i] * fa[0][i] + w[0][1][i] * fb[0][i] + w[0][2][i] * fc[0][i], uA = w[1][0][i] * fa[1][i] + w[1][1][i] * fb[1][i] + w[1][2][i] * fc[1][i];
                    const float gB = w[0][0][i] * fb[0][i] + w[0][1][i] * fc[0][i] + w[0][2][i] * fd[0][i], uB = w[1][0][i] * fb[1][i] + w[1][1][i] * fc[1][i] + w[1][2][i] * fd[1][i];
                    oa[i] = silu_mul(gA, uA); ob[i] = silu_mul(gB, uB);
                }
                v2u o; o.x = pk2(oa[0], oa[1]); o.y = pk2(oa[2], oa[3]); *(v2u*)(BIG + (size_t)(pm * 256 - 1) * DFF + ch) = o;
                o.x = pk2(ob[0], ob[1]); o.y = pk2(ob[2], ob[3]); *(v2u*)(BIG + (size_t)(pm * 256) * DFF + ch) = o;
            }
        }
#endif
        grid.sync();
#ifndef SKIP_P9
        { PH_BEGIN
            pg8::Gemm g{BIG, Wdown, M, DMODEL, DFF}; pg8::StaticOrder S; S.init(M, DMODEL, G, bx);
            pg8::EpiResF32<true> E{outp, outp, outp, A};
            pg8::gemm_phase<pg8::EpiResF32<true>, pg8::StaticOrder, true, true>(ldsl, g, S, E);
        }
#endif
        grid.sync();
#ifndef SKIP_P10
        { PH_BEGIN
            pg8::StaticOrder S; S.init(M, DMODEL, G, bx);
            { pg8::Gemm g{P16, Wproj, M, DMODEL, PLE}; pg8::EpiStoreBf16 E{BIG, DMODEL};
              pg8::gemm_phase<pg8::EpiStoreBf16, pg8::StaticOrder, true, true>(ldsl, g, S, E); }
            __threadfence_block(); __syncthreads();
            { pg8::Gemm g{A, Wgate, M, DMODEL, DMODEL}; pg8::EpiGate E{outp, BIG};
              pg8::gemm_phase<pg8::EpiGate, pg8::StaticOrder, true, true>(ldsl, g, S, E); }
        }
#endif
        grid.sync();
    }
}

extern "C" void kernel_launch(void* const* d_in, const int* in_sizes, int n_in, void* d_out, int out_size, void* d_ws, size_t ws_size, hipStream_t stream) {
    static int grid = 0;
    if (grid == 0) {
        if (n_in != 18 || out_size != M * DMODEL || ws_size < WS_END) { fprintf(stderr, "kernel_launch: unexpected shapes (n_in %d out %d ws %zu)\n", n_in, out_size, ws_size); grid = -1; return; }
        int dev = 0, cus = 0, per_cu = 0;
        if (hipGetDevice(&dev) != hipSuccess || hipDeviceGetAttribute(&cus, hipDeviceAttributeMultiprocessorCount, dev) != hipSuccess) { grid = -1; return; }
        if (hipFuncSetAttribute((const void*)mega_fwd, hipFuncAttributeMaxDynamicSharedMemorySize, LDS_BYTES) != hipSuccess) { fprintf(stderr, "kernel_launch: hipFuncSetAttribute failed\n"); grid = -1; return; }
        if (hipOccupancyMaxActiveBlocksPerMultiprocessor(&per_cu, (const void*)mega_fwd, NWAVES * 64, LDS_BYTES) != hipSuccess || per_cu < 1) { fprintf(stderr, "kernel_launch: occupancy query gave %d\n", per_cu); (void)hipGetLastError(); grid = -1; return; }
        grid = cus * 1;
        fprintf(stderr, "kernel_launch: grid %d (per_cu %d), ws %zu\n", grid, per_cu, ws_size);
    }
    if (grid < 0) return;
    Args a{};
    for (int i = 0; i < 18; ++i) a.p[i] = d_in[i];
    a.p[18] = d_out; a.p[19] = d_ws;
    void* args[] = {&a};
    hipError_t e = hipLaunchCooperativeKernel((void*)mega_fwd, dim3(grid), dim3(NWAVES * 64), args, LDS_BYTES, stream);
    if (e != hipSuccess) fprintf(stderr, "kernel_launch: cooperative launch failed: %s (grid %d)\n", hipGetErrorString(e), grid);
}
```

```cpp
#include <hip/hip_runtime.h>
#include <hip/hip_cooperative_groups.h>
#include <cstdio>
#include <cstdint>
namespace cg = cooperative_groups;
#ifndef PROF_MASK
#define PROF_MASK 0
#endif
namespace pg8 {
#define PG8_LAS __attribute__((address_space(3)))
typedef unsigned short bf16_t;
typedef short bf16x8 __attribute__((ext_vector_type(8)));
typedef float f32x4 __attribute__((ext_vector_type(4)));
typedef unsigned u32x4 __attribute__((ext_vector_type(4)));
constexpr int BM = 256, BK = 64, HALF = 128, HTB = HALF * BK * 2  , STAGE_BYTES = 8 * HTB, NXCD = 8, WGM = 8;

__host__ __device__ __forceinline__ int lds_byte(int r, int c) { const int st = (r >> 4) * 2 + (c >> 5), rr = r & 15, cc = c & 31, ob = rr * 64 + cc * 2; return st * 1024 + (ob ^ (((ob >> 9) & 1) << 5)); }
__host__ __device__ __forceinline__ void stage_rc(int b, int& R, int& C) { const int st = b / 1024, sb = b % 1024, swz = sb ^ (((sb >> 9) & 1) << 5); R = (st >> 1) * 16 + swz / 64; C = (st & 1) * 32 + (swz % 64) / 2; }
__host__ __device__ __forceinline__ int perm32(int rho) { const int n = rho >> 4, i = rho & 15; return 8 * (i >> 2) + 4 * n + (i & 3); }

struct Unit { int pm, pn; };
struct Gemm { const bf16_t* A; const bf16_t* Bt; int M, N, K; };

struct StaticOrder {
    int nM, nN, nwg, G, c;
    __host__ __device__ __forceinline__ void init(int M, int N, int G_, int c_) { nM = M / BM; nN = N / BM; nwg = nM * nN; G = G_; c = c_; }
    __host__ __device__ __forceinline__ bool next(int i, Unit& u) const {
        const long L = (long)i * G + c; if (L >= nwg) return false;
        int wgid = (int)L; { const int q = nwg / NXCD, r = nwg % NXCD, xcd = wgid % NXCD, off = wgid / NXCD; wgid = (xcd < r ? xcd * (q + 1) : r * (q + 1) + (xcd - r) * q) + off; }
        const int nig = WGM * nN, gid = wgid / nig, fm = gid * WGM, gsz = (nM - fm) < WGM ? (nM - fm) : WGM;
        u.pm = fm + ((wgid % nig) % gsz); u.pn = (wgid % nig) / gsz; return true;
    }
    __device__ __forceinline__ void a_ready(const Unit&) const {}
    __device__ __forceinline__ void done(const Unit&) const {}
};

__device__ __forceinline__ unsigned cvt_pk_bf16(float lo, float hi) { unsigned r; asm volatile("v_cvt_pk_bf16_f32 %0, %1, %2" : "=v"(r) : "v"(lo), "v"(hi)); return r; }
typedef float f32x2 __attribute__((ext_vector_type(2)));

typedef unsigned u32x2 __attribute__((ext_vector_type(2)));
__device__ __forceinline__ float bf_lo(unsigned w) { return __uint_as_float(w << 16); }
__device__ __forceinline__ float bf_hi(unsigned w) { return __uint_as_float(w & 0xffff0000u); }
__device__ __forceinline__ float dpp_ror1(float x)  { return __int_as_float(__builtin_amdgcn_update_dpp(0, __float_as_int(x), 0x121, 0xf, 0xf, false)); }
__device__ __forceinline__ float dpp_ror15(float x) { return __int_as_float(__builtin_amdgcn_update_dpp(0, __float_as_int(x), 0x12f, 0xf, 0xf, false)); }
__device__ __forceinline__ float dpp_shr1(float old, float x) { return __int_as_float(__builtin_amdgcn_update_dpp(__float_as_int(old), __float_as_int(x), 0x111, 0xf, 0xf, false)); }
__device__ __forceinline__ float dpp_shl1(float old, float x) { return __int_as_float(__builtin_amdgcn_update_dpp(__float_as_int(old), __float_as_int(x), 0x101, 0xf, 0xf, false)); }


__device__ __forceinline__ float rstd_row(const float* rss, int row, float inv_n) { return rsqrtf(rss[row] * inv_n + 1e-6f); }
struct EpiStoreBf16 {
    static constexpr bool PERM = true, AFTER_DRAIN = false, MIDK = false;
    bf16_t* O; int ldc; const float* rss; float inv_n; int prod_pn;
    __device__ __forceinline__ void operator()(const f32x4 (&acc)[2][2][4][2], const Unit& u, int wr, int wc, int fr, int fq) const {
        const int row0 = u.pm * BM + wr * 64 + fr;
        if (u.pn >= prod_pn) {
            const int col0 = prod_pn * BM + (u.pn - prod_pn) * HALF + wc * 32 + 8 * fq;
#pragma unroll
            for (int ai = 0; ai < 2; ++ai)
#pragma unroll
                for (int m = 0; m < 4; ++m) { const int row = row0 + ai * HALF + m * 16; const float s = rss ? rstd_row(rss, row, inv_n) : 1.f; const float s2 = s * s;
                    const f32x4 v0 = acc[ai][0][m][0] * acc[ai][1][m][0] * s2, v1 = acc[ai][0][m][1] * acc[ai][1][m][1] * s2;
                    u32x4 w; w.x = cvt_pk_bf16(v0[0], v0[1]); w.y = cvt_pk_bf16(v0[2], v0[3]); w.z = cvt_pk_bf16(v1[0], v1[1]); w.w = cvt_pk_bf16(v1[2], v1[3]);
                    *(u32x4*)(O + (size_t)row * ldc + col0) = w; }
            return;
        }
        const int col0 = u.pn * BM + wc * 32 + 8 * fq;
#pragma unroll
        for (int ai = 0; ai < 2; ++ai)
#pragma unroll
            for (int m = 0; m < 4; ++m) { const int row = row0 + ai * HALF + m * 16; bf16_t* rowp = O + (size_t)row * ldc + col0;
                const float s = rss ? rstd_row(rss, row, inv_n) : 1.f;
#pragma unroll
                for (int bj = 0; bj < 2; ++bj) { const f32x4 v0 = acc[ai][bj][m][0] * s, v1 = acc[ai][bj][m][1] * s;
                    u32x4 w; w.x = cvt_pk_bf16(v0[0], v0[1]); w.y = cvt_pk_bf16(v0[2], v0[3]); w.z = cvt_pk_bf16(v1[0], v1[1]); w.w = cvt_pk_bf16(v1[2], v1[3]);
                    *(u32x4*)(rowp + bj * HALF) = w; } }
    }
};
template <bool MIDK_> struct EpiRes {
    static constexpr bool PERM = true, AFTER_DRAIN = false, MIDK = MIDK_; static constexpr int MIDK_T = 8;
    const float* xlo; const float* xhi; const bf16_t* hbase; const bf16_t* pp; bf16_t* hout; float* fout; float* rss; const float* mrss;
    __device__ __forceinline__ void mid(f32x4 (&acc)[2][2][4][2], const Unit& u, int wr, int wc, int fr, int fq) const {
        int z = 0; asm volatile("" : "+v"(z));
        const int rbase = u.pm * BM + wr * 64 + fr + z;
#pragma unroll
        for (int ai = 0; ai < 2; ++ai)
#pragma unroll
            for (int m = 0; m < 4; ++m) { const float s = rstd_row(mrss, rbase + ai * HALF + m * 16, 1.f / 512.f);
#pragma unroll
                for (int bj = 0; bj < 2; ++bj)
#pragma unroll
                    for (int n = 0; n < 2; ++n) acc[ai][bj][m][n] = acc[ai][bj][m][n] * s; }
    }
    __device__ __forceinline__ void operator()(const f32x4 (&acc)[2][2][4][2], const Unit& u, int wr, int wc, int fr, int fq) const {
        const float* xb = (u.pm < 64) ? xlo : xhi;
        const int col0 = u.pn * BM + wc * 32 + 8 * fq;
#pragma unroll
        for (int ai = 0; ai < 2; ++ai) { float ssm[4];
#pragma unroll
            for (int m = 0; m < 4; ++m) { const int row = u.pm * BM + ai * HALF + wr * 64 + m * 16 + fr; const size_t off = (size_t)row * 1024 + col0;
                float ss = 0.f;
#pragma unroll
                for (int bj = 0; bj < 2; ++bj) {
                    float b[8], v[8];
                    if (xlo) { const f32x4 b0 = *(const f32x4*)(xb + off + bj * HALF), b1 = *(const f32x4*)(xb + off + bj * HALF + 4);
                        b[0] = b0[0]; b[1] = b0[1]; b[2] = b0[2]; b[3] = b0[3]; b[4] = b1[0]; b[5] = b1[1]; b[6] = b1[2]; b[7] = b1[3]; }
                    else { const u32x4 w = *(const u32x4*)(hbase + off + bj * HALF);
                        b[0] = bf_lo(w.x); b[1] = bf_hi(w.x); b[2] = bf_lo(w.y); b[3] = bf_hi(w.y); b[4] = bf_lo(w.z); b[5] = bf_hi(w.z); b[6] = bf_lo(w.w); b[7] = bf_hi(w.w); }
#pragma unroll
                    for (int i = 0; i < 4; ++i) { v[i] = acc[ai][bj][m][0][i]; v[4 + i] = acc[ai][bj][m][1][i]; }
                    if (pp) { const u32x4 w = *(const u32x4*)(pp + off + bj * HALF);
                        const float p[8] = {bf_lo(w.x), bf_hi(w.x), bf_lo(w.y), bf_hi(w.y), bf_lo(w.z), bf_hi(w.z), bf_lo(w.w), bf_hi(w.w)};
#pragma unroll
                        for (int i = 0; i < 8; ++i) v[i] = p[i] * __builtin_amdgcn_rcpf(1.f + __builtin_amdgcn_exp2f(-1.4426950408889634f * v[i])); }
#pragma unroll
                    for (int i = 0; i < 8; ++i) v[i] += b[i];
                    if (hout) { u32x4 w; w.x = cvt_pk_bf16(v[0], v[1]); w.y = cvt_pk_bf16(v[2], v[3]); w.z = cvt_pk_bf16(v[4], v[5]); w.w = cvt_pk_bf16(v[6], v[7]);
                        *(u32x4*)(hout + off + bj * HALF) = w;
                        if (rss) { const float r[8] = {bf_lo(w.x), bf_hi(w.x), bf_lo(w.y), bf_hi(w.y), bf_lo(w.z), bf_hi(w.z), bf_lo(w.w), bf_hi(w.w)};
#pragma unroll
                            for (int i = 0; i < 8; ++i) ss += r[i] * r[i]; } }
                    if (fout) { *(f32x4*)(fout + off + bj * HALF) = (f32x4){v[0], v[1], v[2], v[3]}; *(f32x4*)(fout + off + bj * HALF + 4) = (f32x4){v[4], v[5], v[6], v[7]}; }
                }
                if (rss) { ss += __shfl_xor(ss, 16); ss += __shfl_xor(ss, 32); } ssm[m] = ss;
                asm volatile("" ::: "memory"); }
            if (rss) { const float mine = fq == 0 ? ssm[0] : fq == 1 ? ssm[1] : fq == 2 ? ssm[2] : ssm[3];
                __hip_atomic_fetch_add(rss + u.pm * BM + ai * HALF + wr * 64 + 16 * fq + fr, mine, __ATOMIC_RELAXED, __HIP_MEMORY_SCOPE_AGENT); } }
    }
};
struct EpiConvAct {
    static constexpr bool PERM = true, AFTER_DRAIN = false, MIDK = false;
    bf16_t* act; bf16_t* E; const float* cw; PG8_LAS float* H; const float* rss;
    __device__ __forceinline__ void operator()(const f32x4 (&acc)[2][2][4][2], const Unit& u, int wr, int wc, int fr, int fq) const {
        const int ch0 = u.pn * 128 + wc * 32 + 8 * fq;
        float s[2][4];
#pragma unroll
        for (int ai = 0; ai < 2; ++ai)
#pragma unroll
            for (int m = 0; m < 4; ++m) s[ai][m] = rstd_row(rss, u.pm * BM + ai * HALF + wr * 64 + m * 16 + fr, 1.f / 1024.f);
#pragma unroll
        for (int ai = 0; ai < 2; ++ai) { const int seg = 2 * ai + wr;
            if (fr == 0)  { PG8_LAS f32x4* h = (PG8_LAS f32x4*)(H + ((((seg * 2 + 0) * 4 + wc) * 4 + fq) * 16)); const float q = s[ai][0]; h[0] = acc[ai][0][0][0] * q; h[1] = acc[ai][0][0][1] * q; h[2] = acc[ai][1][0][0] * q; h[3] = acc[ai][1][0][1] * q; }
            if (fr == 15) { PG8_LAS f32x4* h = (PG8_LAS f32x4*)(H + ((((seg * 2 + 1) * 4 + wc) * 4 + fq) * 16)); const float q = s[ai][3]; h[0] = acc[ai][0][3][0] * q; h[1] = acc[ai][0][3][1] * q; h[2] = acc[ai][1][3][0] * q; h[3] = acc[ai][1][3][1] * q; } }
        asm volatile("s_waitcnt lgkmcnt(0)" ::: "memory"); __builtin_amdgcn_s_barrier(); asm volatile("" ::: "memory");
#pragma unroll
        for (int n = 0; n < 2; ++n) {
            f32x4 w[2][3];
#pragma unroll
            for (int bj = 0; bj < 2; ++bj)
#pragma unroll
                for (int j = 0; j < 3; ++j) w[bj][j] = *(const f32x4*)(cw + j * 5632 + bj * 2816 + ch0 + 4 * n);
#pragma unroll
            for (int ai = 0; ai < 2; ++ai) { const int seg = 2 * ai + wr;
                f32x4 hp[2], hn[2];
                { const int sp = seg > 0 ? seg - 1 : 0; const PG8_LAS f32x4* h = (const PG8_LAS f32x4*)(H + ((((sp * 2 + 1) * 4 + wc) * 4 + fq) * 16)); hp[0] = h[n]; hp[1] = h[2 + n];
                  if (seg == 0) { hp[0] = (f32x4){0.f, 0.f, 0.f, 0.f}; hp[1] = hp[0]; } }
                { const int sn = seg < 3 ? seg + 1 : 3; const PG8_LAS f32x4* h = (const PG8_LAS f32x4*)(H + ((((sn * 2 + 0) * 4 + wc) * 4 + fq) * 16)); hn[0] = h[n]; hn[1] = h[2 + n];
                  if (seg == 3) { hn[0] = (f32x4){0.f, 0.f, 0.f, 0.f}; hn[1] = hn[0]; } }
                float cv[4][2][4];
#pragma unroll
                for (int bj = 0; bj < 2; ++bj)
#pragma unroll
                    for (int i = 0; i < 4; ++i) {
                        float sv[4];
#pragma unroll
                        for (int m = 0; m < 4; ++m) sv[m] = acc[ai][bj][m][n][i] * s[ai][m];
#pragma unroll
                        for (int m = 0; m < 4; ++m) {
                            const float X = (m > 0) ? dpp_ror1(sv[m > 0 ? m - 1 : 0]) : hp[bj][i];
                            const float Y = (m < 3) ? dpp_ror15(sv[m < 3 ? m + 1 : 3]) : hn[bj][i];
                            const float prv = dpp_shr1(X, sv[m]), nxt = dpp_shl1(Y, sv[m]);
                            cv[m][bj][i] = w[bj][0][i] * prv + w[bj][1][i] * sv[m] + w[bj][2][i] * nxt; }
                    }
#pragma unroll
                for (int m = 0; m < 4; ++m) {
                    float o[4];
#pragma unroll
                    for (int i = 0; i < 4; ++i) o[i] = cv[m][0][i] * __builtin_amdgcn_rcpf(1.f + __builtin_amdgcn_exp2f(-1.4426950408889634f * cv[m][0][i])) * cv[m][1][i];
                    u32x2 pw; pw.x = cvt_pk_bf16(o[0], o[1]); pw.y = cvt_pk_bf16(o[2], o[3]);
                    *(u32x2*)(act + (size_t)(u.pm * BM + ai * HALF + wr * 64 + m * 16 + fr) * 2816 + ch0 + 4 * n) = pw;
                }
            }
            if (wr == 0 && fr < 2) {
#pragma unroll
                for (int bj = 0; bj < 2; ++bj) { const f32x4 v = acc[0][bj][0][n] * s[0][0]; u32x2 pw; pw.x = cvt_pk_bf16(v[0], v[1]); pw.y = cvt_pk_bf16(v[2], v[3]);
                    *(u32x2*)(E + (size_t)(u.pm * 4 + fr) * 5632 + bj * 2816 + ch0 + 4 * n) = pw; } }
            if (wr == 1 && fr >= 14) {
#pragma unroll
                for (int bj = 0; bj < 2; ++bj) { const f32x4 v = acc[1][bj][3][n] * s[1][3]; u32x2 pw; pw.x = cvt_pk_bf16(v[0], v[1]); pw.y = cvt_pk_bf16(v[2], v[3]);
                    *(u32x2*)(E + (size_t)(u.pm * 4 + fr - 12) * 5632 + bj * 2816 + ch0 + 4 * n) = pw; } }
        }
    }
};
template <class Epi, class Sched, bool ALIGN_EPI = false, bool SP2 = false>
__device__ __forceinline__ void gemm_phase(PG8_LAS unsigned char* lds, const Gemm g, const Sched& S, const Epi& E) {
    int tid_ = threadIdx.x; asm volatile("" : "+v"(tid_));
    const int tid = tid_, wid = __builtin_amdgcn_readfirstlane(tid >> 6), lane = tid & 63, wr = wid >> 2, wc = wid & 3, fr = lane & 15, fq = lane >> 4;
    const int K = g.K, nt = K / BK;
    unsigned voffA[2], voffB[2];
#pragma unroll
    for (int i = 0; i < 2; ++i) { int R, C; stage_rc(tid * 16 + i * 8192, R, C); const int Rb = Epi::PERM ? ((R & ~31) + perm32(R & 31)) : R;
        voffA[i] = (unsigned)(R * K + C) * 2u; voffB[i] = (unsigned)(Rb * K + C) * 2u; }
    const size_t kstep = (size_t)(BK * 2);
    const size_t hstep = (size_t)HALF * K * 2;
    const size_t tstep = 2 * hstep;
    const unsigned ldsw = (unsigned)wid * 1024u;
    const int aoff = lds_byte(wr * 64 + fr, fq * 8), boff = lds_byte(wc * 32 + fr, fq * 8);
#define PG8_SA(b, h) (((b) * 2 + (h)) * HTB)
#define PG8_SB(b, h) ((4 + (b) * 2 + (h)) * HTB)
#define PG8_STAGE(bufoff, gbase, voff) do { _Pragma("unroll") for (int _i = 0; _i < 2; ++_i) \
        __builtin_amdgcn_global_load_lds((const unsigned*)((const char*)(gbase) + (voff)[_i]), (PG8_LAS unsigned*)(lds + (bufoff) + ldsw + _i * 8192), 16, 0, 0); } while (0)
#define PG8_LDA(dst, b, h) do { _Pragma("unroll") for (int m = 0; m < 4; ++m) _Pragma("unroll") for (int k = 0; k < 2; ++k) dst[m][k] = *(const PG8_LAS bf16x8*)(lds + PG8_SA(b, h) + aoff + m * 2048 + k * 1024); } while (0)
#define PG8_LDB(dst, b, h) do { _Pragma("unroll") for (int n = 0; n < 2; ++n) _Pragma("unroll") for (int k = 0; k < 2; ++k) dst[n][k] = *(const PG8_LAS bf16x8*)(lds + PG8_SB(b, h) + boff + n * 2048 + k * 1024); } while (0)
#define PG8_MMA(ai, bj, At, Bt) do { __builtin_amdgcn_s_setprio(1); _Pragma("unroll") for (int m = 0; m < 4; ++m) _Pragma("unroll") for (int n = 0; n < 2; ++n) _Pragma("unroll") for (int k = 0; k < 2; ++k) \
        acc[ai][bj][m][n] = __builtin_amdgcn_mfma_f32_16x16x32_bf16(Bt[n][k], At[m][k], acc[ai][bj][m][n], 0, 0, 0); __builtin_amdgcn_s_setprio(0); } while (0)
#define PG8_WAIT_V(n) asm volatile("s_waitcnt vmcnt(" #n ")" ::: "memory")
#define PG8_WAIT_L(n) asm volatile("s_waitcnt lgkmcnt(" #n ")" ::: "memory")
#define PG8_BAR __builtin_amdgcn_s_barrier()
#define PG8_SCHED __builtin_amdgcn_sched_barrier(0)
    Unit cur, nxt; int ui = 0;
    if (!S.next(0, cur)) return;
    f32x4 acc[2][2][4][2];
#pragma unroll
    for (int a = 0; a < 2; ++a)
#pragma unroll
        for (int b = 0; b < 2; ++b)
#pragma unroll
            for (int m = 0; m < 4; ++m)
#pragma unroll
                for (int n = 0; n < 2; ++n) acc[a][b][m][n] = (f32x4){0.f, 0.f, 0.f, 0.f};
    bf16x8 At[4][2], B0[2][2], B1[2][2];
    const char* cA = (const char*)g.A + (size_t)cur.pm * tstep; const char* cB = (const char*)g.Bt + (size_t)cur.pn * tstep;
    S.a_ready(cur);
    if constexpr (SP2) {
        PG8_STAGE(PG8_SB(0, 0), cB, voffB); PG8_STAGE(PG8_SB(0, 1), cB + hstep, voffB); PG8_STAGE(PG8_SA(0, 0), cA, voffA); PG8_STAGE(PG8_SA(0, 1), cA + hstep, voffA);
        if (wr == 1) PG8_BAR;
        PG8_WAIT_V(2); PG8_BAR;
        PG8_STAGE(PG8_SB(1, 0), cB + kstep, voffB); PG8_STAGE(PG8_SA(1, 0), cA + kstep, voffA); PG8_STAGE(PG8_SB(1, 1), cB + hstep + kstep, voffB);
        PG8_WAIT_V(6); PG8_BAR;
    } else {
        PG8_STAGE(PG8_SB(0, 0), cB, voffB); PG8_STAGE(PG8_SA(0, 0), cA, voffA); PG8_STAGE(PG8_SB(0, 1), cB + hstep, voffB); PG8_STAGE(PG8_SA(0, 1), cA + hstep, voffA);
        if (wr == 1) PG8_BAR;
        PG8_WAIT_V(4); PG8_BAR;
        PG8_STAGE(PG8_SB(1, 0), cB + kstep, voffB); PG8_STAGE(PG8_SA(1, 0), cA + kstep, voffA); PG8_STAGE(PG8_SB(1, 1), cB + hstep + kstep, voffB);
        PG8_WAIT_V(6); PG8_BAR;
    }
    for (;;) {
        const bool has_next = S.next(ui + 1, nxt);
        const char* nA = has_next ? (const char*)g.A + (size_t)nxt.pm * tstep : cA; const char* nB = has_next ? (const char*)g.Bt + (size_t)nxt.pn * tstep : cB;
        for (int t = 0; t < nt; t += 2) {
            if constexpr (Epi::MIDK) { if (t == Epi::MIDK_T) E.mid(acc, cur, wr, wc, fr, fq); }
            const bool last = (t == nt - 2);
            const char* a1 = cA + (size_t)(t + 1) * kstep;
            const char* a2 = last ? nA : cA + (size_t)(t + 2) * kstep; const char* b2 = last ? nB : cB + (size_t)(t + 2) * kstep;
            const char* a3 = a2 + kstep; const char* b3 = b2 + kstep;
            if (last && has_next) S.a_ready(nxt);
            if constexpr (SP2) {
            PG8_LDB(B0, 0, 0); PG8_LDB(B1, 0, 1); PG8_SCHED; PG8_LDA(At, 0, 0); PG8_STAGE(PG8_SA(1, 1), a1 + hstep, voffA);
            PG8_WAIT_V(8); PG8_WAIT_L(0); PG8_BAR; PG8_MMA(0, 0, At, B0); PG8_MMA(0, 1, At, B1); PG8_BAR; PG8_SCHED;
            PG8_LDA(At, 0, 1); PG8_STAGE(PG8_SB(0, 0), b2, voffB); PG8_STAGE(PG8_SB(0, 1), b2 + hstep, voffB); PG8_STAGE(PG8_SA(0, 0), a2, voffA);
            PG8_WAIT_V(8); PG8_WAIT_L(0); PG8_BAR; PG8_MMA(1, 0, At, B0); PG8_MMA(1, 1, At, B1); PG8_BAR; PG8_SCHED;
            PG8_LDB(B0, 1, 0); PG8_LDB(B1, 1, 1); PG8_SCHED; PG8_LDA(At, 1, 0); PG8_STAGE(PG8_SA(0, 1), a2 + hstep, voffA);
            PG8_WAIT_V(8); PG8_WAIT_L(0); PG8_BAR; PG8_MMA(0, 0, At, B0); PG8_MMA(0, 1, At, B1); PG8_BAR; PG8_SCHED;
            PG8_LDA(At, 1, 1); PG8_STAGE(PG8_SB(1, 0), b3, voffB); PG8_STAGE(PG8_SB(1, 1), b3 + hstep, voffB); PG8_STAGE(PG8_SA(1, 0), a3, voffA);
            PG8_WAIT_V(8); PG8_WAIT_L(0); PG8_BAR; PG8_MMA(1, 0, At, B0); PG8_MMA(1, 1, At, B1); PG8_BAR; PG8_SCHED;
            } else {
            PG8_LDB(B0, 0, 0); PG8_SCHED; PG8_LDA(At, 0, 0); PG8_STAGE(PG8_SA(1, 1), a1 + hstep, voffA);
            PG8_WAIT_L(8); PG8_BAR; PG8_WAIT_L(0); PG8_MMA(0, 0, At, B0); PG8_BAR; PG8_SCHED;
            PG8_LDB(B1, 0, 1); PG8_STAGE(PG8_SB(0, 0), b2, voffB);
            PG8_BAR; PG8_WAIT_L(0); PG8_MMA(0, 1, At, B1); PG8_BAR;
            PG8_LDA(At, 0, 1); PG8_STAGE(PG8_SA(0, 0), a2, voffA);
            PG8_BAR; PG8_WAIT_L(0); PG8_MMA(1, 0, At, B0); PG8_BAR; PG8_SCHED;
            PG8_STAGE(PG8_SB(0, 1), b2 + hstep, voffB);
            PG8_WAIT_V(6); PG8_BAR; PG8_MMA(1, 1, At, B1); PG8_BAR;
            PG8_LDB(B0, 1, 0); PG8_SCHED; PG8_LDA(At, 1, 0); PG8_STAGE(PG8_SA(0, 1), a2 + hstep, voffA);
            PG8_WAIT_L(8); PG8_BAR; PG8_WAIT_L(0); PG8_MMA(0, 0, At, B0); PG8_BAR; PG8_SCHED;
            PG8_LDB(B1, 1, 1); PG8_STAGE(PG8_SB(1, 0), b3, voffB);
            PG8_BAR; PG8_WAIT_L(0); PG8_MMA(0, 1, At, B1); PG8_BAR;
            PG8_LDA(At, 1, 1); PG8_STAGE(PG8_SA(1, 0), a3, voffA);
            PG8_BAR; PG8_WAIT_L(0); PG8_MMA(1, 0, At, B0); PG8_BAR; PG8_SCHED;
            PG8_STAGE(PG8_SB(1, 1), b3 + hstep, voffB);
            PG8_WAIT_V(6); PG8_BAR; PG8_MMA(1, 1, At, B1); PG8_BAR;
            }
        }
        if constexpr (ALIGN_EPI) { if (wr == 0) PG8_BAR; }
        if constexpr (!Epi::AFTER_DRAIN) { E(acc, cur, wr, wc, fr, fq); S.done(cur); }
        if (!has_next) break;
#pragma unroll
        for (int a = 0; a < 2; ++a)
#pragma unroll
            for (int b = 0; b < 2; ++b)
#pragma unroll
                for (int m = 0; m < 4; ++m)
#pragma unroll
                    for (int n = 0; n < 2; ++n) acc[a][b][m][n] = (f32x4){0.f, 0.f, 0.f, 0.f};
        cur = nxt; cA = nA; cB = nB; ++ui;
        if constexpr (ALIGN_EPI) { if (wr == 1) PG8_BAR; }
    }
    PG8_WAIT_V(0);
    if constexpr (!ALIGN_EPI) { if (wr == 0) PG8_BAR; }
    PG8_BAR;
    if constexpr (Epi::AFTER_DRAIN) { E.fused(acc, cur, wr, wc, fr, fq, lds, wid, lane); S.done(cur); }
#undef PG8_SA
#undef PG8_SB
#undef PG8_STAGE
#undef PG8_LDA
#undef PG8_LDB
#undef PG8_MMA
#undef PG8_WAIT_V
#undef PG8_WAIT_L
#undef PG8_BAR
#undef PG8_SCHED
}
}
#include <hip/hip_bf16.h>
#include <cmath>
namespace attn_body {
using bf16=__hip_bfloat16;
using bf16x8=__attribute__((ext_vector_type(8)))short;
using s16x4=__attribute__((ext_vector_type(4)))short;
using f32x16=__attribute__((ext_vector_type(16)))float;
using u32x4=__attribute__((ext_vector_type(4)))unsigned;
constexpr int D=64,ZP=1792,OP=1024;
constexpr int NW=8,QBLK=32,QB=QBLK*NW,KVBLK=64;
__device__ __forceinline__ int crow(int r,int hi){return (r&3)+8*(r>>2)+4*hi;}
#define SBAR() __builtin_amdgcn_sched_barrier(0)
__device__ __forceinline__ void cmask(f32x16&p0,f32x16&p1,int jb,int qrel,int hi){
  const float NEG=-INFINITY; int kb=64*jb+4*hi;
  #pragma unroll
  for(int r=0;r<16;++r){int kv=kb+(r&3)+8*(r>>2); if(kv>qrel)p0[r]=NEG; if(kv+32>qrel)p1[r]=NEG;}
}

constexpr int NSLOT=3, SLOTB=8192;
constexpr int LDS_K=0, LDS_V=NSLOT*SLOTB, LDS_WS=2*NSLOT*SLOTB, LDS_OST=LDS_WS+NW*64*4, LDS_BYTES=LDS_OST+NW*4096;
constexpr float C2=0.125f*1.4426950408889634f;
__device__ __forceinline__ void glds16(const void*gsrc,unsigned lds_dst){unsigned keep;
  asm volatile("s_mov_b32 %0, m0\n\ts_mov_b32 m0, %2\n\ts_nop 0\n\tglobal_load_lds_dwordx4 %1, off\n\ts_mov_b32 m0, %0":"=&s"(keep):"v"(gsrc),"s"(lds_dst):"memory");}
__device__ __forceinline__ float max3f(float a,float b,float c){float r;asm("v_max3_f32 %0, %1, %2, %3":"=v"(r):"v"(a),"v"(b),"v"(c));return r;}
__device__ __forceinline__ float max2f(float a,float b){float r;asm("v_max_f32_e32 %0, %1, %2":"=v"(r):"v"(a),"v"(b));return r;}
__device__ __forceinline__ float fadd_s(float a,float b){float r;asm("v_add_f32_e32 %0, %1, %2":"=v"(r):"v"(a),"v"(b));return r;}
__device__ __forceinline__ float fsub_s(float a,float b){float r;asm("v_sub_f32_e32 %0, %1, %2":"=v"(r):"v"(a),"v"(b));return r;}
typedef float f32x2_t __attribute__((ext_vector_type(2))); typedef __bf16 bf16x2_t __attribute__((ext_vector_type(2)));
__device__ __forceinline__ unsigned cvtpk_s(float lo,float hi){f32x2_t v={lo,hi};bf16x2_t b=__builtin_convertvector(v,bf16x2_t);return __builtin_bit_cast(unsigned,b);}
#define WAIT_BAR(N) asm volatile("s_waitcnt vmcnt(" #N ") lgkmcnt(0)\n\ts_barrier":::"memory")

__device__ __forceinline__ void qkt(f32x16&p0,f32x16&p1,const char*Kslot,const bf16x8*qr,const f32x16&negm,int r32,int hi){
  const char*kb=Kslot+hi*1024+r32*16;
  #pragma unroll
  for(int d0=0;d0<4;++d0){
    const bf16x8 b0=*reinterpret_cast<const bf16x8*>(kb+d0*2048);
    const bf16x8 b1=*reinterpret_cast<const bf16x8*>(kb+d0*2048+512);
    if(d0==0){p0=__builtin_amdgcn_mfma_f32_32x32x16_bf16(b0,qr[0],negm,0,0,0);p1=__builtin_amdgcn_mfma_f32_32x32x16_bf16(b1,qr[0],negm,0,0,0);}
    else{p0=__builtin_amdgcn_mfma_f32_32x32x16_bf16(b0,qr[d0],p0,0,0,0);p1=__builtin_amdgcn_mfma_f32_32x32x16_bf16(b1,qr[d0],p1,0,0,0);}}
}
typedef __attribute__((address_space(3))) const char* lds_cptr;
typedef short v4i16_t __attribute__((ext_vector_type(4)));
__device__ __forceinline__ void kload8(bf16x8*kf,lds_cptr kp){
  kf[0]=*(const __attribute__((address_space(3))) bf16x8*)(kp);      kf[1]=*(const __attribute__((address_space(3))) bf16x8*)(kp+512);
  kf[2]=*(const __attribute__((address_space(3))) bf16x8*)(kp+2048); kf[3]=*(const __attribute__((address_space(3))) bf16x8*)(kp+2560);
  kf[4]=*(const __attribute__((address_space(3))) bf16x8*)(kp+4096); kf[5]=*(const __attribute__((address_space(3))) bf16x8*)(kp+4608);
  kf[6]=*(const __attribute__((address_space(3))) bf16x8*)(kp+6144); kf[7]=*(const __attribute__((address_space(3))) bf16x8*)(kp+6656);
}
__device__ __forceinline__ void kload2(bf16x8*kf,lds_cptr kp,int j){ kf[2*j]=*(const __attribute__((address_space(3))) bf16x8*)(kp+j*2048); kf[2*j+1]=*(const __attribute__((address_space(3))) bf16x8*)(kp+j*2048+512); }
__device__ __forceinline__ s16x4 vtr(lds_cptr p){ return __builtin_bit_cast(s16x4,__builtin_amdgcn_ds_read_tr16_b64_v4i16((__attribute__((address_space(3))) v4i16_t*)p)); }
__device__ __forceinline__ float rowmax(const f32x16&p0,const f32x16&p1){
  float a=max3f(p0[0],p0[1],p1[0]),b=max3f(p0[2],p0[3],p1[1]);a=max3f(a,p1[2],p1[3]);
  #pragma unroll
  for(int r=4;r<16;r+=4){a=max3f(a,p0[r],p0[r+1]);b=max3f(b,p0[r+2],p0[r+3]);a=max3f(a,p1[r],p1[r+1]);b=max3f(b,p1[r+2],p1[r+3]);}
  const float m=max2f(a,b);
  auto rr=__builtin_amdgcn_permlane32_swap(__float_as_uint(m),__float_as_uint(m),false,false);
  return max2f(__uint_as_float(rr[0]),__uint_as_float(rr[1]));
}
__device__ __forceinline__ void pv(f32x16*o,int vb,bf16x8 pa0,bf16x8 pa1,bf16x8 pa2,bf16x8 pa3){
  #pragma unroll
  for(int d0=0;d0<2;++d0){s16x4 lo[4],hi[4];
    #pragma unroll
    for(int ks=0;ks<4;++ks){
      asm volatile("ds_read_b64_tr_b16 %0,%1 offset:%c2":"=&v"(lo[ks]):"v"(vb),"i"(d0*4096+ks*1024):"memory");
      asm volatile("ds_read_b64_tr_b16 %0,%1 offset:%c2":"=&v"(hi[ks]):"v"(vb),"i"(d0*4096+ks*1024+512):"memory");}
    asm volatile("s_waitcnt lgkmcnt(0)":::"memory");SBAR();
    #define PK(k) (bf16x8){lo[k][0],lo[k][1],lo[k][2],lo[k][3],hi[k][0],hi[k][1],hi[k][2],hi[k][3]}
    o[d0]=__builtin_amdgcn_mfma_f32_32x32x16_bf16(pa0,PK(0),o[d0],0,0,0);
    o[d0]=__builtin_amdgcn_mfma_f32_32x32x16_bf16(pa1,PK(1),o[d0],0,0,0);
    o[d0]=__builtin_amdgcn_mfma_f32_32x32x16_bf16(pa2,PK(2),o[d0],0,0,0);
    o[d0]=__builtin_amdgcn_mfma_f32_32x32x16_bf16(pa3,PK(3),o[d0],0,0,0);
    #undef PK
  }
}

#ifndef ATTN_STORE16
#define ATTN_STORE16(p,v) (*(u32x4*)(p)=(v))
#endif
template<int THRL> __device__ __forceinline__ void attn_unit(long rowbase,int S,int h,int qb,const bf16*__restrict__ Z,bf16*O,float*rss,const float*__restrict__ qg,const float*__restrict__ rope,char*shm){
  int tid_=threadIdx.x; asm volatile("":"+v"(tid_)); const int tid=tid_,lane=tid&63,r32=lane&31,hi=lane>>5; const int wid=__builtin_amdgcn_readfirstlane(tid>>6);
  const int q0=qb*QB;
  const bf16*Qw=Z+(rowbase+q0+wid*QBLK)*ZP+h*D;
  const bf16*Kh=Z+rowbase*ZP+512+(h>>2)*D,*Vh=Z+rowbase*ZP+640+(h>>2)*D;
  const unsigned lds0=(unsigned)(uintptr_t)shm;
  float*wsf=(float*)(shm+LDS_WS)+wid*64;
  const bf16*ksrc=Kh+(long)lane*ZP+wid*8;
  const bf16*vsrc=Vh+(long)(16*(wid&3)+(lane>>2))*ZP+(wid>>2)*32+(lane&3)*8;
  const unsigned kdst=lds0+LDS_K+wid*1024, vdst=lds0+LDS_V+wid*1024;
  #define DMA_K(t,slot) glds16(ksrc+(long)(t)*KVBLK*ZP,(unsigned)__builtin_amdgcn_readfirstlane(kdst+(slot)))
  #define DMA_V(t,slot) glds16(vsrc+(long)(t)*KVBLK*ZP,(unsigned)__builtin_amdgcn_readfirstlane(vdst+(slot)))
  const int vb0=(int)(lds0+LDS_V)+((lane>>4)&1)*32+(lane&3)*8+(4*hi+((lane&15)>>2))*64;
  const char*Kbase=shm+LDS_K; bf16x8 kf[8];
  const lds_cptr shm3=(lds_cptr)shm; const lds_cptr kp0=shm3+LDS_K+hi*1024+r32*16; const lds_cptr vp0=shm3+LDS_V+((lane>>4)&1)*32+(lane&3)*8+(4*hi+((lane&15)>>2))*64;
  const int NT=S/KVBLK;
  DMA_K(0,0);DMA_V(0,0);DMA_K(1,SLOTB);
  bf16x8 qr[4];
  #pragma unroll
  for(int d0=0;d0<4;++d0)qr[d0]=*reinterpret_cast<const bf16x8*>(&Qw[(long)r32*ZP+d0*16+hi*8]);
  float mhat=0.f,l_reg=0.f;f32x16 o[2];o[0]=f32x16{};o[1]=f32x16{};f32x16 negm=f32x16{};asm volatile("":"+v"(negm));
  const int qrel=wid*QBLK+r32;
  #define CMASK(P0,P1,t) do{}while(0)
  bool resc=false;
  #define START(P0,P1) do{ const float rm=rowmax(P0,P1); resc=false; \
    { const float dl=rm; mhat=fadd_s(mhat,dl); \
      _Pragma("unroll") for(int r=0;r<16;++r){P0[r]=fsub_s(P0[r],dl);P1[r]=fsub_s(P1[r],dl);} \
      _Pragma("unroll") for(int r=0;r<16;++r)negm[r]=-mhat; asm volatile("":"+v"(negm)); } \
    _Pragma("unroll") for(int r=0;r<16;++r)P0[r]=__builtin_amdgcn_exp2f(P0[r]); }while(0)
  #define RESC() do{ if(resc){ asm volatile("s_waitcnt lgkmcnt(0)":::"memory"); \
      _Pragma("unroll") for(int d_=0;d_<2;++d_) _Pragma("unroll") for(int r=0;r<16;++r)o[d_][r]*=wsf[crow(r,hi)]; } }while(0)
  f32x16 pA0,pA1,pB0,pB1;
  int sl_prev=0,sl_cur=0,sl_next=SLOTB;
  #define ROT() do{sl_prev=sl_cur;sl_cur=sl_next;sl_next=(sl_next==(NSLOT-1)*SLOTB)?0:sl_next+SLOTB;}while(0)
  DMA_K(2,2*SLOTB);
  {
    const int tq=q0+wid*QBLK+r32; float x[4][8]; float ss=0.f;
    #pragma unroll
    for(int d0=0;d0<4;++d0){
      #pragma unroll
      for(int j=0;j<8;++j){x[d0][j]=__uint_as_float((unsigned)(unsigned short)qr[d0][j]<<16); ss+=x[d0][j]*x[d0][j];}}
    {auto rr=__builtin_amdgcn_permlane32_swap(__float_as_uint(ss),__float_as_uint(ss),false,false); ss=__uint_as_float(rr[0])+__uint_as_float(rr[1]);}
    const float rstd=__builtin_amdgcn_rsqf(ss*(1.f/64.f)+1e-6f);
    #pragma unroll
    for(int d0=0;d0<4;++d0){
      #pragma unroll
      for(int j=0;j<8;++j)x[d0][j]*=rstd*qg[16*d0+8*hi+j];}
    const float*tr=rope+(size_t)((tq>>6)*16+8*hi)*2,*tc=rope+(size_t)((tq&63)*16+8*hi)*2;
    #pragma unroll
    for(int j=0;j<8;++j){
      const float cr=tr[2*j],sr=tr[2*j+1],cc=tc[2*j],sc=tc[2*j+1];
      const float a=x[0][j],b=x[1][j],e=x[2][j],f=x[3][j];
      x[0][j]=(a*cr-b*sr)*C2; x[1][j]=(b*cr+a*sr)*C2; x[2][j]=(e*cc-f*sc)*C2; x[3][j]=(f*cc+e*sc)*C2;}
    #pragma unroll
    for(int d0=0;d0<4;++d0){u32x4 w; w[0]=cvtpk_s(x[d0][0],x[d0][1]);w[1]=cvtpk_s(x[d0][2],x[d0][3]);w[2]=cvtpk_s(x[d0][4],x[d0][5]);w[3]=cvtpk_s(x[d0][6],x[d0][7]); qr[d0]=__builtin_bit_cast(bf16x8,w);}
  }
  WAIT_BAR(3);
  qkt(pA0,pA1,Kbase,qr,negm,r32,hi);asm volatile("s_nop 15\n\ts_nop 7":"+v"(pA0),"+v"(pA1));CMASK(pA0,pA1,0);
  START(pA0,pA1);
  _Pragma("unroll") for(int r=0;r<16;++r)pA1[r]=__builtin_amdgcn_exp2f(pA1[r]);
  WAIT_BAR(0);
  DMA_K(3,0);DMA_V(1,SLOTB);
  ROT();
  kload8(kf,kp0+sl_cur);
  WAIT_BAR(2);
  s16x4 vlo[8],vhi[8]; u32x4 pw0,pw1,pw2,pw3;
  #define PKW(P,B) cvtpk_s(P[B],P[B+1])
  #define PAF(k) __builtin_bit_cast(bf16x8,pw##k)
  #define VFR(i) (bf16x8){vlo[i][0],vlo[i][1],vlo[i][2],vlo[i][3],vhi[i][0],vhi[i][1],vhi[i][2],vhi[i][3]}
  #define PIN(x) asm volatile("":"+v"(x))
  #define MX3(a,b,c) __builtin_fmaxf(__builtin_fmaxf((a),(b)),(c))
  #define GAPA(MF,A0,A1,A2,A3,W0,W1,PW) do{ MF; sacc+=A0; sacc+=A1; sacc+=A2; sacc+=A3; PIN(sacc); W0; W1; PIN(PW); SBAR(); }while(0)
  #define EX(v) __builtin_amdgcn_exp2f(v)
  #define GAPB(MF,X,B) do{ MF; X[B]=EX(X[B]); X[B+1]=EX(X[B+1]); X[B+2]=EX(X[B+2]); X[B+3]=EX(X[B+3]); PIN(X); SBAR(); }while(0)
  #define VRD(i) do{ vlo[i]=vtr(vp_+(((i)>>2)*4096+((i)&3)*1024)); vhi[i]=vtr(vp_+(((i)>>2)*4096+((i)&3)*1024+512)); }while(0)
  #define KRD(G,j) do{ if(G){ kload2(kf,kp0+sl_next,j); SBAR(); } }while(0)
  #define STEP(C0,C1,P0,P1,t,GK,GV,GL) do{ SBAR(); \
    const lds_cptr vp_=vp0+sl_prev; \
    VRD(0); SBAR(); float sacc=(P0[0]+P0[1]); \
    GAPA(C0=__builtin_amdgcn_mfma_f32_32x32x16_bf16(kf[0],qr[0],negm,0,0,0), P0[2],P0[3],P0[4],P0[5],     pw0[0]=PKW(P0,0), pw0[1]=PKW(P0,2), pw0); \
    VRD(4); SBAR(); GAPA(C1=__builtin_amdgcn_mfma_f32_32x32x16_bf16(kf[1],qr[0],negm,0,0,0), P0[6],P0[7],P0[8],P0[9],     pw0[2]=PKW(P0,4), pw0[3]=PKW(P0,6), pw0); \
    VRD(1); SBAR(); GAPA(C0=__builtin_amdgcn_mfma_f32_32x32x16_bf16(kf[2],qr[1],C0,0,0,0),   P0[10],P0[11],P0[12],P0[13], pw1[0]=PKW(P0,8), pw1[1]=PKW(P0,10), pw1); \
    VRD(5); SBAR(); GAPA(C1=__builtin_amdgcn_mfma_f32_32x32x16_bf16(kf[3],qr[1],C1,0,0,0),   P0[14],P0[15],P1[0],P1[1],   pw1[2]=PKW(P0,12),pw1[3]=PKW(P0,14), pw1); \
    VRD(2); SBAR(); GAPA(C0=__builtin_amdgcn_mfma_f32_32x32x16_bf16(kf[4],qr[2],C0,0,0,0),   P1[2],P1[3],P1[4],P1[5],     pw2[0]=PKW(P1,0), pw2[1]=PKW(P1,2), pw2); \
    VRD(6); SBAR(); GAPA(C1=__builtin_amdgcn_mfma_f32_32x32x16_bf16(kf[5],qr[2],C1,0,0,0),   P1[6],P1[7],P1[8],P1[9],     pw2[2]=PKW(P1,4), pw2[3]=PKW(P1,6), pw2); \
    VRD(3); SBAR(); GAPA(C0=__builtin_amdgcn_mfma_f32_32x32x16_bf16(kf[6],qr[3],C0,0,0,0),   P1[10],P1[11],P1[12],P1[13], pw3[0]=PKW(P1,8), pw3[1]=PKW(P1,10), pw3); \
    VRD(7); SBAR(); GAPA(C1=__builtin_amdgcn_mfma_f32_32x32x16_bf16(kf[7],qr[3],C1,0,0,0),   P1[14],P1[15],0.f,0.f,       pw3[2]=PKW(P1,12),pw3[3]=PKW(P1,14), pw3); \
    l_reg+=sacc; \
    if(GK){DMA_K((t)+3,sl_cur);} if(GV){DMA_V((t)+1,sl_next);} \
    CMASK(C0,C1,t); \
    { float a=MX3(C0[0],C0[1],C1[0]),b=MX3(C0[2],C0[3],C1[1]); a=MX3(a,C1[2],C1[3]); \
      _Pragma("unroll") for(int r=4;r<16;r+=4){a=MX3(a,C0[r],C0[r+1]);b=MX3(b,C0[r+2],C0[r+3]);a=MX3(a,C1[r],C1[r+1]);b=MX3(b,C1[r+2],C1[r+3]);} \
      float rm=__builtin_fmaxf(a,b); { auto rr=__builtin_amdgcn_permlane32_swap(__float_as_uint(rm),__float_as_uint(rm),false,false); rm=__builtin_fmaxf(__uint_as_float(rr[0]),__uint_as_float(rr[1])); } \
      resc=false; \
      if(__builtin_expect(__any(rm>(float)THRL),0)){ const float dl=__builtin_fmaxf(rm,0.f); mhat+=dl; \
        _Pragma("unroll") for(int r=0;r<16;++r){C0[r]-=dl;C1[r]-=dl;} \
        _Pragma("unroll") for(int r=0;r<16;++r)negm[r]=-mhat; asm volatile("":"+v"(negm)); \
        const float f=__builtin_amdgcn_exp2f(-dl); l_reg*=f; if(hi==0)wsf[r32]=f; resc=true; } } \
    SBAR(); \
    GAPB(o[0]=__builtin_amdgcn_mfma_f32_32x32x16_bf16(PAF(0),VFR(0),o[0],0,0,0), C0,0); \
    GAPB(o[1]=__builtin_amdgcn_mfma_f32_32x32x16_bf16(PAF(0),VFR(4),o[1],0,0,0), C0,4); \
    KRD(GL,0); GAPB(o[0]=__builtin_amdgcn_mfma_f32_32x32x16_bf16(PAF(1),VFR(1),o[0],0,0,0), C0,8); \
    KRD(GL,1); GAPB(o[1]=__builtin_amdgcn_mfma_f32_32x32x16_bf16(PAF(1),VFR(5),o[1],0,0,0), C0,12); \
    KRD(GL,2); GAPB(o[0]=__builtin_amdgcn_mfma_f32_32x32x16_bf16(PAF(2),VFR(2),o[0],0,0,0), C1,0); \
    KRD(GL,3); GAPB(o[1]=__builtin_amdgcn_mfma_f32_32x32x16_bf16(PAF(2),VFR(6),o[1],0,0,0), C1,4); \
    GAPB(o[0]=__builtin_amdgcn_mfma_f32_32x32x16_bf16(PAF(3),VFR(3),o[0],0,0,0), C1,8); \
    GAPB(o[1]=__builtin_amdgcn_mfma_f32_32x32x16_bf16(PAF(3),VFR(7),o[1],0,0,0), C1,12); \
    }while(0)
  int t=1;
  #undef CMASK
  #define CMASK(P0,P1,t) do{}while(0)
  for(;t+5<NT;t+=2){
    STEP(pB0,pB1,pA0,pA1,t,true,true,true);     WAIT_BAR(2); RESC(); ROT();
    STEP(pA0,pA1,pB0,pB1,t+1,true,true,true);   WAIT_BAR(2); RESC(); ROT();
  }
  #undef CMASK
  #define CMASK(P0,P1,t) do{}while(0)
  #define ENDW(tt) do{ if((tt)+3<NT){WAIT_BAR(2);} else if((tt)+2<NT){WAIT_BAR(1);} else {WAIT_BAR(0);} }while(0)
  for(;t+1<NT;t+=2){
    STEP(pB0,pB1,pA0,pA1,t,(t+3<NT),(t+1<NT),(t+1<NT));       ENDW(t);   RESC(); ROT();
    STEP(pA0,pA1,pB0,pB1,t+1,(t+4<NT),(t+2<NT),(t+2<NT));     ENDW(t+1); RESC(); ROT();
  }
  STEP(pB0,pB1,pA0,pA1,NT-1,false,false,false); RESC();
  { float sacc=pB0[0]+pB0[1]; _Pragma("unroll") for(int r=2;r<16;++r)sacc+=pB0[r]; _Pragma("unroll") for(int r=0;r<16;++r)sacc+=pB1[r]; l_reg+=sacc;
    pw0=(u32x4){PKW(pB0,0),PKW(pB0,2),PKW(pB0,4),PKW(pB0,6)};pw1=(u32x4){PKW(pB0,8),PKW(pB0,10),PKW(pB0,12),PKW(pB0,14)};pw2=(u32x4){PKW(pB1,0),PKW(pB1,2),PKW(pB1,4),PKW(pB1,6)};pw3=(u32x4){PKW(pB1,8),PKW(pB1,10),PKW(pB1,12),PKW(pB1,14)};
    SBAR(); pv(o,vb0+sl_cur,PAF(0),PAF(1),PAF(2),PAF(3)); }
  #undef PKW
  #undef PAF
  #undef VFR
  #undef PIN
  #undef MX3
  #undef GAPA
  #undef GAPB
  #undef EX
  #undef VRD
  #undef KRD
  #undef STEP
  #undef ENDW
  {auto rr=__builtin_amdgcn_permlane32_swap(__float_as_uint(l_reg),__float_as_uint(l_reg),false,false);l_reg=__uint_as_float(rr[0])+__uint_as_float(rr[1]);}
  if(hi==0)wsf[32+r32]=l_reg;asm volatile("s_waitcnt lgkmcnt(0)":::"memory");
  float rli[16];
  #pragma unroll
  for(int r=0;r<16;++r)rli[r]=__builtin_amdgcn_rcpf(wsf[32+crow(r,hi)]);
  bf16*Ow=O+(rowbase+q0+wid*QBLK)*OP+h*D;
  { bf16*stg=(bf16*)(shm+LDS_OST)+wid*2048;
    #pragma unroll
    for(int r=0;r<16;++r){const int orow=crow(r,hi);
      #pragma unroll
      for(int d0=0;d0<2;++d0)stg[orow*64+d0*32+r32]=__float2bfloat16(o[d0][r]*rli[r]);}
    asm volatile("s_waitcnt lgkmcnt(0)":::"memory");
    float rs4[4];
    #pragma unroll
    for(int i=0;i<4;++i){const int row=i*8+(lane>>3),ch=lane&7; const u32x4 v=*(const u32x4*)(stg+row*64+ch*8); ATTN_STORE16(Ow+(long)row*OP+ch*8,v);
      float s=0.f;
      #pragma unroll
      for(int j=0;j<4;++j){const float lo=__uint_as_float(v[j]<<16),hh=__uint_as_float(v[j]&0xffff0000u); s+=lo*lo+hh*hh;}
      s+=__shfl_xor(s,1);s+=__shfl_xor(s,2);s+=__shfl_xor(s,4); rs4[i]=s;}
    { const int ch=lane&7;
      const float mine=ch==0?rs4[0]:ch==1?rs4[1]:ch==2?rs4[2]:rs4[3];
      if(ch<4)__hip_atomic_fetch_add(rss+rowbase+q0+wid*QBLK+ch*8+(lane>>3),mine,__ATOMIC_RELAXED,__HIP_MEMORY_SCOPE_AGENT);} }
  asm volatile("s_waitcnt lgkmcnt(0)\n\ts_barrier":::"memory");
  #undef DMA_K
  #undef DMA_V
  #undef CMASK
  #undef START
  #undef RESC
  #undef ROT
}
constexpr int ATTN_LDS_BYTES=LDS_BYTES;
#undef SBAR
#undef WAIT_BAR
}
#define LAS __attribute__((address_space(3)))
#define XB_TMO      128
#define XB_XCNT(j)  (256  + 64 * (j))
#define XB_XSUB(j)  (1280 + 64 * (j))
#define XB_XGEN(j)  (2304 + 64 * (j))
#define XB_TOP      3328
#define XB_TOPGEN   3392
#define XCD_BAR_WORDS 3456
#define XB_SPIN_CAP (1u << 18)

__device__ __forceinline__ unsigned xb_ld(unsigned* p)              { return __hip_atomic_load(p, __ATOMIC_RELAXED, __HIP_MEMORY_SCOPE_AGENT); }
__device__ __forceinline__ unsigned xb_add(unsigned* p, unsigned v) { return __hip_atomic_fetch_add(p, v, __ATOMIC_RELAXED, __HIP_MEMORY_SCOPE_AGENT); }
__device__ __forceinline__ unsigned xb_xcc_id() { return (unsigned)__builtin_amdgcn_s_getreg((3 << 11) | 20) & 0xFu; }
#define XB_SPIN(cond, bar) do { unsigned _sp = 0; while (cond) { __builtin_amdgcn_s_sleep(1); \
    if ((++_sp & 255u) == 0u) { if (xb_ld(&(bar)[XB_TMO])) break; if (_sp > XB_SPIN_CAP) { atomicAdd(&(bar)[XB_TMO], 1u); break; } } } } while (0)

struct XcdBarrier {
    unsigned* bar; unsigned x;
    volatile LAS unsigned* st;
};

__device__ __forceinline__ XcdBarrier xcd_barrier_post(unsigned* bar, volatile LAS unsigned* st) {
    XcdBarrier b; b.bar = bar; b.x = xb_xcc_id(); b.st = st;
    if (threadIdx.x == 0) (void)xb_add(&bar[XB_XCNT(b.x)], 1u);
    return b;
}
__device__ __forceinline__ void xcd_barrier_complete(unsigned* bar, unsigned x, unsigned& nloc, unsigned& nx) {
    const unsigned G = gridDim.x * gridDim.y * gridDim.z;
    unsigned sum, cnt, mine, sp = 0u;
    for (;;) {
        sum = 0u; cnt = 0u; mine = 0u;
#pragma unroll
        for (unsigned j = 0; j < 16; ++j) { const unsigned c = xb_ld(&bar[XB_XCNT(j)]); sum += c; cnt += (c > 0u) ? 1u : 0u; mine = (j == x) ? c : mine; }
        if (sum == G) break;
        __builtin_amdgcn_s_sleep(1);
        if ((++sp & 255u) == 0u) { if (xb_ld(&bar[XB_TMO])) break; if (sp > XB_SPIN_CAP) { atomicAdd(&bar[XB_TMO], 1u); break; } }
    }
    nloc = mine > 0u ? mine : 1u; nx = cnt > 0u ? cnt : 1u;
}

__device__ __forceinline__ void xcd_barrier(const XcdBarrier& b) {
    asm volatile("s_waitcnt vmcnt(0)" ::: "memory");
    __syncthreads();
    if (threadIdx.x == 0) {
        unsigned* bar = b.bar;
        __builtin_amdgcn_s_waitcnt(0);
        unsigned nloc = b.st[0], nx = b.st[1];
        if (nloc == 0u) { xcd_barrier_complete(bar, b.x, nloc, nx); b.st[0] = nloc; b.st[1] = nx; }
        const unsigned old = xb_add(&bar[XB_XSUB(b.x)], 1u);
        const unsigned gen = old / nloc;
        if (old + 1u == (gen + 1u) * nloc) {
            __builtin_amdgcn_fence(__ATOMIC_RELEASE, "agent");
            asm volatile("s_waitcnt vmcnt(0)" ::: "memory");
            const unsigned og = xb_add(&bar[XB_TOP], 1u);
            const unsigned tg = og / nx;
            if (og + 1u == (tg + 1u) * nx) xb_add(&bar[XB_TOPGEN], 1u);
            else XB_SPIN(xb_ld(&bar[XB_TOPGEN]) == tg, bar);
            __builtin_amdgcn_fence(__ATOMIC_ACQUIRE, "agent");
            xb_add(&bar[XB_XGEN(b.x)], 1u);
            asm volatile("s_waitcnt vmcnt(0)" ::: "memory");
        } else {
            XB_SPIN(xb_ld(&bar[XB_XGEN(b.x)]) == gen, bar);
            __builtin_amdgcn_fence(__ATOMIC_ACQUIRE, "agent");
            asm volatile("s_waitcnt vmcnt(0)" ::: "memory");
        }
    }
    __syncthreads();
}

constexpr int NWAVES = 8;
constexpr int M = 32768, MP = 16384, DMODEL = 1024, DIN = 2304, ZW = 1792  , DFF = 2816, NUP = 5632, PLE = 256, SP = 4096, SS = 2048;
constexpr float EPS = 1e-6f;
constexpr size_t MiB = 1u << 20;
constexpr size_t WS_ROPE = 0;
constexpr size_t WS_WIN = 1 * MiB;
constexpr size_t WS_WOUT = WS_WIN + (size_t)DIN * DMODEL * 2;
constexpr size_t WS_WUP = WS_WOUT + (size_t)DMODEL * DMODEL * 2;
constexpr size_t WS_WDOWN = WS_WUP + (size_t)NUP * DMODEL * 2;
constexpr size_t WS_WGATE = WS_WDOWN + (size_t)DMODEL * DFF * 2;
constexpr size_t WS_WPROJ = WS_WGATE + (size_t)DMODEL * DMODEL * 2;
constexpr size_t WS_RSS = 27 * MiB;
constexpr size_t WS_A = 28 * MiB;
constexpr size_t WS_BIG = 92 * MiB;
constexpr size_t WS_W2 = 268 * MiB;
constexpr size_t HB_E = 32 * MiB;
constexpr size_t WS_P16 = 274 * MiB;
constexpr size_t WS_END = 290 * MiB;
static_assert(WS_WPROJ + (size_t)DMODEL * PLE * 2 <= WS_A, "weights fit");
constexpr int RING_BYTES = 131072, MISC_OFF = RING_BYTES, HALO_OFF = RING_BYTES + 1024, LDS_BYTES = 147456;
constexpr size_t WS_CTL = 512 * 1024, CTL_BYTES = 64 * 1024;

typedef unsigned short bf16;
typedef unsigned v4u __attribute__((ext_vector_type(4)));
typedef unsigned v2u __attribute__((ext_vector_type(2)));
typedef float f32x4 __attribute__((ext_vector_type(4)));

__device__ __forceinline__ unsigned pk2(float lo, float hi) { return pg8::cvt_pk_bf16(lo, hi); }
__device__ __forceinline__ float bflo(unsigned w) { return __uint_as_float(w << 16); }
__device__ __forceinline__ float bfhi(unsigned w) { return __uint_as_float(w & 0xffff0000u); }
__device__ __forceinline__ void unpack8(const v4u v, float* f) { f[0] = bflo(v.x); f[1] = bfhi(v.x); f[2] = bflo(v.y); f[3] = bfhi(v.y); f[4] = bflo(v.z); f[5] = bfhi(v.z); f[6] = bflo(v.w); f[7] = bfhi(v.w); }
__device__ __forceinline__ v4u pack8(const float* f) { v4u o; o.x = pk2(f[0], f[1]); o.y = pk2(f[2], f[3]); o.z = pk2(f[4], f[5]); o.w = pk2(f[6], f[7]); return o; }
#define DPPF(x, ctrl) __int_as_float(__builtin_amdgcn_update_dpp(0, __float_as_int(x), (ctrl), 0xf, 0xf, false))
__device__ __forceinline__ float sum8(float v) {
    v += DPPF(v, 0xB1); v += DPPF(v, 0x4E); v += DPPF(v, 0x141); return v;
}
__device__ __forceinline__ float wave_sum(float v) {
    v = sum8(v); v += DPPF(v, 0x128);
    return __int_as_float(__builtin_amdgcn_readlane(__float_as_int(v), 0)) + __int_as_float(__builtin_amdgcn_readlane(__float_as_int(v), 16))
         + __int_as_float(__builtin_amdgcn_readlane(__float_as_int(v), 32)) + __int_as_float(__builtin_amdgcn_readlane(__float_as_int(v), 48));
}
struct Args { void* p[20]; };

struct TItem { const float* W; bf16* WT; const float* ks; int K, N, mode, kmax, item; };
__device__ __forceinline__ void titem_load(const TItem& t, f32x4 (&v)[8], int lane) {
    const int nblk = t.N / 32, kb = t.item / nblk, nb = t.item % nblk, k0 = 64 * kb, n0 = 32 * nb;
#pragma unroll
    for (int i = 0; i < 8; ++i) { const int kk = 8 * i + (lane >> 3), nq = (lane & 7) * 4; v[i] = __builtin_nontemporal_load((const f32x4*)(t.W + (size_t)(k0 + kk) * t.N + n0 + nq)); }
}
__device__ __forceinline__ void titem_finish(const TItem& t, f32x4 (&v)[8], float* scr, int lane) {
    const int nblk = t.N / 32, kb = t.item / nblk, nb = t.item % nblk, k0 = 64 * kb, n0 = 32 * nb;
#pragma unroll
    for (int i = 0; i < 8; ++i) { const int kk = 8 * i + (lane >> 3), nq = (lane & 7) * 4; f32x4 x = v[i];
        if (t.ks && k0 + kk < t.kmax) x = x * t.ks[k0 + kk];
        float* d = scr + kk * 33 + nq; d[0] = x.x; d[1] = x.y; d[2] = x.z; d[3] = x.w; }
    __builtin_amdgcn_s_waitcnt(0xc07f); asm volatile("" ::: "memory");
    int r0 = n0;
    if (t.mode == 1) { r0 = (n0 < DFF) ? 256 * (n0 / 128) + n0 % 128 : 256 * ((n0 - DFF) / 128) + 128 + (n0 - DFF) % 128; }
    if (t.mode == 2 && n0 >= 1280) { r0 = (n0 < 1792) ? 1280 + 256 * ((n0 - 1280) / 128) + (n0 - 1280) % 128 : 1280 + 256 * ((n0 - 1792) / 128) + 128 + (n0 - 1792) % 128; }
    const int c = lane & 7;
#pragma unroll
    for (int j = 0; j < 4; ++j) { const int n = (lane >> 3) + 8 * j; const float* s = scr + (8 * c) * 33 + n;
        v4u o; o.x = pk2(s[0 * 33], s[1 * 33]); o.y = pk2(s[2 * 33], s[3 * 33]); o.z = pk2(s[4 * 33], s[5 * 33]); o.w = pk2(s[6 * 33], s[7 * 33]);
        *(v4u*)(t.WT + (size_t)(r0 + n) * t.K + k0 + 8 * c) = o; }
    __builtin_amdgcn_s_waitcnt(0xc07f); asm volatile("" ::: "memory");
}
__device__ __forceinline__ void transpose_matrix(const float* W, int K, int N, bf16* WT, int mode, const float* ks, int kmax, float* scr, int start, int stride, int lane) {
    const int nitems = (K / 64) * (N / 32);
    for (int it = start; it < nitems; it += 2 * stride) {
        const bool two = it + stride < nitems;
        TItem t0{W, WT, ks, K, N, mode, kmax, it}; TItem t1 = t0; t1.item = two ? it + stride : it;
        f32x4 v0[8], v1[8];
        titem_load(t0, v0, lane); titem_load(t1, v1, lane);
        titem_finish(t0, v0, scr, lane);
        if (two) titem_finish(t1, v1, scr, lane);
    }
}
__device__ __forceinline__ void xrow_load(const float* xrow, f32x4 (&v)[4], int lane) {
    const f32x4* xr = (const f32x4*)xrow + lane;
#pragma unroll
    for (int j = 0; j < 4; ++j) v[j] = __builtin_nontemporal_load(xr + 64 * j);
}
__device__ __forceinline__ void xrow_finish(const f32x4 (&v)[4], bf16* orow, float* rss, int lane) {
    v2u* o8 = (v2u*)orow + lane; float s = 0.f;
#pragma unroll
    for (int j = 0; j < 4; ++j) { v2u o; o.x = pk2(v[j].x, v[j].y); o.y = pk2(v[j].z, v[j].w); o8[64 * j] = o;
        const float a = bflo(o.x), b = bfhi(o.x), c = bflo(o.y), d = bfhi(o.y); s += (a * a + b * b) + (c * c + d * d); }
    s = wave_sum(s); if (lane == 0) *rss = s;
}
__device__ __forceinline__ void prow_cvt(const float* pr, bf16* orow, int lane) {
    const f32x4 pv = __builtin_nontemporal_load((const f32x4*)pr + lane); v2u o; o.x = pk2(pv.x, pv.y); o.y = pk2(pv.z, pv.w); ((v2u*)orow)[lane] = o;
}
constexpr float ATT_C2 = 0.125f * 1.4426950408889634f;
struct MixIn { v4u k, gb, gu[3]; f32x4 rp[4]; };
struct MixPar { float kg[8], cw[3][8], cog[8]; };
__device__ __forceinline__ void mix_par(MixPar& p, const float* kg, const float* cw, const float* cog, int lane) {
    const int c = lane & 7, ch = lane * 8;
#pragma unroll
    for (int j = 0; j < 8; ++j) { p.kg[j] = kg[c * 8 + j]; p.cog[j] = cog[ch + j]; p.cw[0][j] = cw[ch + j]; p.cw[1][j] = cw[512 + ch + j]; p.cw[2][j] = cw[1024 + ch + j]; }
}
__device__ __forceinline__ void mix_load(int row, const bf16* Z, const float* rope, MixIn& r, int lane) {
    const int S = row < MP ? SP : SS, t = row & (S - 1);
    const bf16* zr = Z + (size_t)row * ZW; const int ch = lane * 8;
    r.k = *(const v4u*)(zr + 512 + (lane & 15) * 8);
    r.gb = *(const v4u*)(zr + 768 + ch); r.gu[1] = *(const v4u*)(zr + 1280 + ch);
    const v4u z4 = {0u, 0u, 0u, 0u};
    if (t > 0) r.gu[0] = *(const v4u*)(zr - ZW + 1280 + ch); else r.gu[0] = z4;
    if (t < S - 1) r.gu[2] = *(const v4u*)(zr + ZW + 1280 + ch); else r.gu[2] = z4;
    const int c = lane & 7, pos = (c >> 2) ? (t & 63) : (t >> 6);
    const f32x4* rp = (const f32x4*)(rope + (size_t)(pos * 16 + (c & 1) * 8) * 2);
#pragma unroll
    for (int j = 0; j < 4; ++j) r.rp[j] = rp[j];
}
struct RowX { v4u k, gb; f32x4 rp[4]; };
__device__ __forceinline__ void rowx_load(int row, const bf16* Z, const float* rope, RowX& r, int lane) {
    const int S = row < MP ? SP : SS, t = row & (S - 1);
    const bf16* zr = Z + (size_t)row * ZW;
    r.k = *(const v4u*)(zr + 512 + (lane & 15) * 8); r.gb = *(const v4u*)(zr + 768 + lane * 8);
    const int c = lane & 7, pos = (c >> 2) ? (t & 63) : (t >> 6);
    const f32x4* rp = (const f32x4*)(rope + (size_t)(pos * 16 + (c & 1) * 8) * 2);
#pragma unroll
    for (int j = 0; j < 4; ++j) r.rp[j] = rp[j];
}
__device__ __forceinline__ v4u gu_load(int row, bool valid, const bf16* Z, int lane) {
    const v4u z4 = {0u, 0u, 0u, 0u};
    return valid ? *(const v4u*)(Z + (size_t)row * ZW + 1280 + lane * 8) : z4;
}
__device__ __forceinline__ void mix_finish(int row, const MixIn& r, const MixPar& P, bf16* Z, bf16* MIX, int lane);
__device__ __forceinline__ void mix_finish_w(int row, const v4u gm, const v4u g0, const v4u gp, const RowX& x, const MixPar& P, bf16* Z, bf16* MIX, int lane) {
    MixIn r; r.k = x.k; r.gb = x.gb; r.gu[0] = gm; r.gu[1] = g0; r.gu[2] = gp;
#pragma unroll
    for (int j = 0; j < 4; ++j) r.rp[j] = x.rp[j];
    mix_finish(row, r, P, Z, MIX, lane);
}
__device__ __forceinline__ void mix_finish(int row, const MixIn& r, const MixPar& P, bf16* Z, bf16* MIX, int lane) {
    bf16* zr = Z + (size_t)row * ZW;
    const int c = lane & 7;
    float cs[8], sn[8];
#pragma unroll
    for (int j = 0; j < 4; ++j) { cs[2 * j] = r.rp[j].x; sn[2 * j] = r.rp[j].y; cs[2 * j + 1] = r.rp[j].z; sn[2 * j + 1] = r.rp[j].w; }
    const float sgn = (c & 2) ? 1.f : -1.f;
    {
        bf16* p = zr + 512 + (lane & 15) * 8;
        float v[8]; unpack8(r.k, v);
        float ss = 0.f;
#pragma unroll
        for (int j = 0; j < 8; ++j) ss += v[j] * v[j];
        const float rstd = rsqrtf(sum8(ss) * (1.f / 64.f) + EPS);
        float o[8];
#pragma unroll
        for (int j = 0; j < 8; ++j) v[j] = v[j] * rstd * P.kg[j];
#pragma unroll
        for (int j = 0; j < 8; ++j) { const float pr = DPPF(v[j], 0x4E); o[j] = v[j] * cs[j] + sgn * pr * sn[j]; }
        if (lane < 16) *(v4u*)p = pack8(o);
    }
    {
        const int ch = lane * 8;
        float gb[8], a[8], acc[8];
        unpack8(r.gb, gb);
#pragma unroll
        for (int j = 0; j < 8; ++j) acc[j] = 0.f;
#pragma unroll
        for (int d = 0; d < 3; ++d) { unpack8(r.gu[d], a);
#pragma unroll
            for (int j = 0; j < 8; ++j) acc[j] += P.cw[d][j] * a[j]; }
        float ss = 0.f;
#pragma unroll
        for (int j = 0; j < 8; ++j) { acc[j] *= gb[j]; ss += acc[j] * acc[j]; }
        const float rstd = rsqrtf(wave_sum(ss) * (1.f / 512.f) + EPS);
#pragma unroll
        for (int j = 0; j < 8; ++j) acc[j] = acc[j] * rstd * P.cog[j];
        *(v4u*)(MIX + (size_t)row * DMODEL + 512 + ch) = pack8(acc);
    }
}
__device__ __forceinline__ void kprep4(int row0, bf16* Z, const float* kg, const float* rope, int lane) {
    const int row = row0 + (lane >> 4), S = row < MP ? SP : SS, t = row & (S - 1), c = lane & 7;
    bf16* p = Z + (size_t)row * ZW + 512 + (lane & 15) * 8;
    const int pos = (c >> 2) ? (t & 63) : (t >> 6);
    const f32x4* rp = (const f32x4*)(rope + (size_t)(pos * 16 + (c & 1) * 8) * 2);
    float v[8]; unpack8(*(const v4u*)p, v);
    float cs[8], sn[8];
#pragma unroll
    for (int j = 0; j < 4; ++j) { const f32x4 x = rp[j]; cs[2 * j] = x.x; sn[2 * j] = x.y; cs[2 * j + 1] = x.z; sn[2 * j + 1] = x.w; }
    const float sgn = (c & 2) ? 1.f : -1.f;
    float ss = 0.f;
#pragma unroll
    for (int j = 0; j < 8; ++j) ss += v[j] * v[j];
    const float rstd = rsqrtf(sum8(ss) * (1.f / 64.f) + EPS);
    float o[8];
#pragma unroll
    for (int j = 0; j < 8; ++j) v[j] = v[j] * rstd * kg[c * 8 + j];
#pragma unroll
    for (int j = 0; j < 8; ++j) { const float pr = DPPF(v[j], 0x4E); o[j] = v[j] * cs[j] + sgn * pr * sn[j]; }
    *(v4u*)p = pack8(o);
}
__device__ __forceinline__ void conv_finish(int row, const v4u gm, const v4u g0, const v4u gp, const v4u gbv, const MixPar& P, bf16* MIX, int lane) {
    const int ch = lane * 8;
    float gb[8], a[8], acc[8];
    unpack8(gbv, gb);
#pragma unroll
    for (int j = 0; j < 8; ++j) acc[j] = 0.f;
    unpack8(gm, a);
#pragma unroll
    for (int j = 0; j < 8; ++j) acc[j] += P.cw[0][j] * a[j];
    unpack8(g0, a);
#pragma unroll
    for (int j = 0; j < 8; ++j) acc[j] += P.cw[1][j] * a[j];
    unpack8(gp, a);
#pragma unroll
    for (int j = 0; j < 8; ++j) acc[j] += P.cw[2][j] * a[j];
    float ss = 0.f;
#pragma unroll
    for (int j = 0; j < 8; ++j) { acc[j] *= gb[j]; ss += acc[j] * acc[j]; }
    const float rstd = rsqrtf(wave_sum(ss) * (1.f / 512.f) + EPS);
#pragma unroll
    for (int j = 0; j < 8; ++j) acc[j] = acc[j] * rstd * P.cog[j];
    *(v4u*)(MIX + (size_t)row * DMODEL + 512 + ch) = pack8(acc);
}
__device__ __forceinline__ void conv_chunk(int r0, int rpw, const bf16* Z, bf16* MIX, const MixPar& P, int lane) {
    const int S = r0 < MP ? SP : SS;
    v4u gm = gu_load(r0 - 1, (r0 & (S - 1)) != 0, Z, lane), g0 = gu_load(r0, true, Z, lane), g1 = gu_load(r0 + 1, true, Z, lane), g2 = gu_load(r0 + 2, true, Z, lane);
    v4u b0 = *(const v4u*)(Z + (size_t)r0 * ZW + 768 + lane * 8), b1 = *(const v4u*)(Z + (size_t)(r0 + 1) * ZW + 768 + lane * 8);
#pragma unroll 1
    for (int i = 0; i < rpw; i += 2) { const int r = r0 + i; const bool more = i + 2 < rpw;
        v4u n1 = g1, n2 = g2, nb0 = b0, nb1 = b1;
        if (more) { n1 = gu_load(r + 3, true, Z, lane); n2 = gu_load(r + 4, ((r + 4) & (S - 1)) != 0, Z, lane);
            nb0 = *(const v4u*)(Z + (size_t)(r + 2) * ZW + 768 + lane * 8); nb1 = *(const v4u*)(Z + (size_t)(r + 3) * ZW + 768 + lane * 8); }
        conv_finish(r, gm, g0, g1, b0, P, MIX, lane); conv_finish(r + 1, g0, g1, g2, b1, P, MIX, lane);
        gm = g1; g0 = g2; g1 = n1; g2 = n2; b0 = nb0; b1 = nb1; }
}
__device__ __forceinline__ float silu_mul(float g, float u) { return g * __builtin_amdgcn_rcpf(1.f + __builtin_amdgcn_exp2f(-1.4426950408889634f * g)) * u; }

__global__ void __launch_bounds__(NWAVES * 64, 2) mega_fwd(Args a) {
    extern __shared__ __attribute__((aligned(16))) unsigned char lds[];
    cg::grid_group grid = cg::this_grid();
    if (threadIdx.x < 64) ((LAS unsigned*)((LAS unsigned char*)lds + MISC_OFF))[threadIdx.x] = 0u;
    __syncthreads();
    if (blockIdx.x == 0) { unsigned* cw = (unsigned*)((unsigned char*)a.p[19] + WS_CTL); for (int i = threadIdx.x; i < XCD_BAR_WORDS; i += NWAVES * 64) cw[i] = 0u; }
    XcdBarrier bar; bar.bar = (unsigned*)((unsigned char*)a.p[19] + WS_CTL); bar.x = 0; bar.st = (volatile LAS unsigned*)((LAS unsigned char*)lds + MISC_OFF);
#define GSYNC() xcd_barrier(bar)
#define PH_BEGIN \
    int tid_ = threadIdx.x; asm volatile("" : "+v"(tid_)); int zi = 0; asm volatile("" : "+s"(zi)); \
    const int tid = tid_, lane = tid & 63, wave = __builtin_amdgcn_readfirstlane(tid >> 6); \
    const int G = gridDim.x + zi, bx = blockIdx.x + zi; \
    const int vcu = (G % 8 == 0) ? (bx % 8) * (G / 8) + bx / 8 : bx; \
    const int gw = vcu * NWAVES + wave, NGW = G * NWAVES; \
    unsigned char* ws = (unsigned char*)a.p[19 + zi]; float* outp = (float*)a.p[18 + zi]; \
    float* rope = (float*)(ws + WS_ROPE); \
    float* RSS_IN = (float*)(ws + WS_RSS); float* RSS_FFN = RSS_IN + 2 * M; float* RSS_ATT = RSS_IN + 4 * M; \
    bf16* HA = (bf16*)outp; unsigned char* HBb = (unsigned char*)outp + (size_t)M * DMODEL * 2; bf16* A = (bf16*)(ws + WS_A); \
    unsigned char* wb = (l == 0) ? ws + WS_WIN : HBb;                        \
    bf16* Win = (bf16*)wb; bf16* Wout = (bf16*)(wb + (WS_WOUT - WS_WIN)); bf16* Wup = (bf16*)(wb + (WS_WUP - WS_WIN)); bf16* Wdown = (bf16*)(wb + (WS_WDOWN - WS_WIN)); \
    bf16* Wgate = (bf16*)(l == 0 ? ws + WS_WGATE : ws + WS_W2); bf16* Wproj = Wgate + (size_t)DMODEL * DMODEL; \
    bf16* RES = (l == 0) ? HA : A;  bf16* MIX = (l == 0) ? A : HA;            \
    bf16* BIG = (bf16*)(ws + WS_BIG); bf16* EB = (bf16*)(HBb + HB_E); bf16* P16 = (bf16*)(ws + WS_P16); \
    LAS unsigned char* ldsl = (LAS unsigned char*)lds; \
    (void)tid; (void)lane; (void)wave; (void)vcu; (void)gw; (void)NGW; (void)rope; (void)Win; (void)Wout; (void)Wup; (void)Wdown; (void)Wgate; (void)Wproj; (void)A; (void)BIG; (void)EB; (void)P16; (void)ldsl; (void)outp; (void)RSS_IN; (void)RSS_FFN; (void)RSS_ATT; (void)HA; (void)RES; (void)MIX;
#define IN(k) ((const float*)a.p[(k) + zi])
#if PROF_MASK
    unsigned long long tprev = __builtin_amdgcn_s_memrealtime(), tacc = 0;
#define STAMP(k) do { const unsigned long long tn_ = __builtin_amdgcn_s_memrealtime(); if ((PROF_MASK >> (k)) & 1) tacc += tn_ - tprev; tprev = tn_; } while (0)
#else
#define STAMP(k) do {} while (0)
#endif
#pragma unroll 1
    for (int l = 0; l < 2; ++l) {
        if (l == 0) {
#ifndef SKIP_P0
        { PH_BEGIN
            float* scr = (float*)(lds + wave * 16384);
            constexpr int I_IN = (DMODEL / 64) * (DIN / 32), I_OUT = (DMODEL / 64) * (DMODEL / 32), I_UP = (DMODEL / 64) * (NUP / 32), I_DOWN = (DFF / 64) * (DMODEL / 32), I_GATE = I_OUT, I_PROJ = (PLE / 64) * (DMODEL / 32);
            int cum = 0;
#pragma unroll 1
            for (int ly = 0; ly < 2; ++ly) {
                unsigned char* wb_ = ly == 0 ? ws + WS_WIN : HBb; bf16* wg_ = (bf16*)(ly == 0 ? ws + WS_WGATE : ws + WS_W2);
                transpose_matrix(IN(5) + (size_t)ly * DMODEL * DIN, DMODEL, DIN, (bf16*)wb_, 2, IN(4) + ly * DMODEL, DMODEL, scr, (gw + NGW - cum % NGW) % NGW, NGW, lane); cum += I_IN;
                transpose_matrix(IN(11) + (size_t)ly * DMODEL * DMODEL, DMODEL, DMODEL, (bf16*)(wb_ + (WS_WOUT - WS_WIN)), 0, IN(9) + ly * 512, 512, scr, (gw + NGW - cum % NGW) % NGW, NGW, lane); cum += I_OUT;
                transpose_matrix(IN(13) + (size_t)ly * DMODEL * NUP, DMODEL, NUP, (bf16*)(wb_ + (WS_WUP - WS_WIN)), 1, IN(12) + ly * DMODEL, DMODEL, scr, (gw + NGW - cum % NGW) % NGW, NGW, lane); cum += I_UP;
                transpose_matrix(IN(15) + (size_t)ly * DFF * DMODEL, DFF, DMODEL, (bf16*)(wb_ + (WS_WDOWN - WS_WIN)), 0, nullptr, 0, scr, (gw + NGW - cum % NGW) % NGW, NGW, lane); cum += I_DOWN;
                transpose_matrix(IN(16) + (size_t)ly * DMODEL * DMODEL, DMODEL, DMODEL, wg_, 0, nullptr, 0, scr, (gw + NGW - cum % NGW) % NGW, NGW, lane); cum += I_GATE;
                transpose_matrix(IN(17) + (size_t)ly * PLE * DMODEL, PLE, DMODEL, wg_ + (size_t)DMODEL * DMODEL, 0, nullptr, 0, scr, (gw + NGW - cum % NGW) % NGW, NGW, lane); cum += I_PROJ;
            }
            const float* xp = IN(0); const float* xs = IN(1); const float* pp_ = IN(2); const float* ps_ = IN(3);
            for (int m = gw; m < M; m += 4 * NGW) {
                f32x4 v[4][4];
#pragma unroll
                for (int q = 0; q < 4; ++q) { const int mm = m + q * NGW; xrow_load(mm < MP ? xp + (size_t)mm * DMODEL : xs + (size_t)(mm - MP) * DMODEL, v[q], lane); }
#pragma unroll
                for (int q = 0; q < 4; ++q) { const int mm = m + q * NGW; prow_cvt(mm < MP ? pp_ + (size_t)mm * PLE : ps_ + (size_t)(mm - MP) * PLE, P16 + (size_t)mm * PLE, lane); }
#pragma unroll
                for (int q = 0; q < 4; ++q) { const int mm = m + q * NGW; xrow_finish(v[q], HA + (size_t)mm * DMODEL, RSS_IN + mm, lane); }
            }
            { const int gt = bx * (NWAVES * 64) + tid;
                for (int i = gt; i < 5 * M; i += G * NWAVES * 64) RSS_IN[M + i] = 0.f;
                if (gt < 1024) { const int pos = gt >> 4, j = gt & 15; const float fr = __builtin_amdgcn_exp2f(-(float)j * 0.8304820237218406f); const float ang = (float)pos * fr;
                    const float rev = ang * 0.15915494309189535f; rope[2 * gt] = __builtin_amdgcn_cosf(rev); rope[2 * gt + 1] = __builtin_amdgcn_sinf(rev); } }
        }
#endif
        grid.sync();
        bar = xcd_barrier_post((unsigned*)((unsigned char*)a.p[19] + WS_CTL), (volatile LAS unsigned*)((LAS unsigned char*)lds + MISC_OFF));
        STAMP(0);
        }
#ifndef SKIP_P1
        { PH_BEGIN
            pg8::Gemm g{RES, Win, M, DIN, DMODEL}; pg8::StaticOrder S; S.init(M, DIN, G, bx);
            pg8::EpiStoreBf16 E{BIG, ZW, RSS_IN + (size_t)l * M, 1.f / 1024.f, 5};
            pg8::gemm_phase<pg8::EpiStoreBf16, pg8::StaticOrder, true, true>(ldsl, g, S, E);
        }
#endif
        GSYNC(); STAMP(1);
#ifndef SKIP_P2
        { PH_BEGIN
            const float* kg = IN(7) + l * 64; const float* cw = IN(8) + l * 3 * 512; const float* cog = IN(10) + l * 512;
            const int rpw = M / NGW, r0 = gw * rpw;
            for (int i = 0; i < rpw; i += 4) kprep4(r0 + i, BIG, kg, rope, lane);
            MixPar P; mix_par(P, kg, cw, cog, lane);
            conv_chunk(r0, rpw, BIG, MIX, P, lane);
        }
#endif
        GSYNC(); STAMP(2);
#ifndef SKIP_P3
        { PH_BEGIN
            const float* qg = IN(6) + l * 64;
            const int u0 = (int)(((long)vcu * 512) / G), u1 = (int)(((long)(vcu + 1) * 512) / G);
            for (int u = u0; u < u1; ++u) { const int bh = u >> 4, qb = u & 15; attn_body::attn_unit<8>((long)(bh >> 3) * SP, SP, bh & 7, qb, (const attn_body::bf16*)BIG, (attn_body::bf16*)MIX, RSS_ATT + (size_t)l * M, qg, rope, (char*)lds); }
            for (int u = u0; u < u1; ++u) { const int bh = u >> 3, qb = u & 7; attn_body::attn_unit<8>((long)MP + (long)(bh >> 3) * SS, SS, bh & 7, qb, (const attn_body::bf16*)BIG, (attn_body::bf16*)MIX, RSS_ATT + (size_t)l * M, qg, rope, (char*)lds); }
        }
#endif
        GSYNC(); STAMP(3);
#ifndef SKIP_P5
        { PH_BEGIN
            pg8::Gemm g{MIX, Wout, M, DMODEL, DMODEL}; pg8::StaticOrder S; S.init(M, DMODEL, G, bx);
            pg8::EpiRes<true> E{nullptr, nullptr, RES, nullptr, RES, nullptr, RSS_FFN + (size_t)l * M, RSS_ATT + (size_t)l * M};
            pg8::gemm_phase<pg8::EpiRes<true>, pg8::StaticOrder, true, true>(ldsl, g, S, E);
        }
#endif
        GSYNC(); STAMP(5);
#ifndef SKIP_P7
        { PH_BEGIN
            pg8::Gemm g{RES, Wup, M, NUP, DMODEL}; pg8::StaticOrder S; S.init(M, NUP, G, bx);
            pg8::EpiConvAct E{BIG, EB, IN(14) + (size_t)l * 3 * NUP, (LAS float*)(ldsl + HALO_OFF), RSS_FFN + (size_t)l * M};
            pg8::gemm_phase<pg8::EpiConvAct, pg8::StaticOrder, true, true>(ldsl, g, S, E);
        }
#endif
        GSYNC(); STAMP(7);
#ifndef SKIP_P9
        { PH_BEGIN
            pg8::StaticOrder S; S.init(M, DMODEL, G, bx);
            if (l == 1) { const float* pp_ = IN(2) + (size_t)MP * PLE; const float* ps_ = IN(3) + (size_t)MP * PLE;
                for (int m = gw; m < M; m += NGW) prow_cvt(m < MP ? pp_ + (size_t)m * PLE : ps_ + (size_t)(m - MP) * PLE, P16 + (size_t)m * PLE, lane); }
            {
                const float* cw = IN(14) + (size_t)l * 3 * NUP; pg8::Unit u;
                for (int i = 0; S.next(i, u); ++i)
#pragma unroll 1
                    for (int e = 0; e < 2; ++e) {
                        const int pm = u.pm, per = pm < 64 ? 16 : 8, ps = pm < 64 ? pm : pm - 64;
                        if (e == 0 ? (ps % per == 0) : (ps % per == per - 1)) continue;
                        const int row = e == 0 ? pm * 256 : pm * 256 + 255;
                        const bf16* ra = e == 0 ? EB + (size_t)((pm - 1) * 4 + 3) * NUP : EB + (size_t)(pm * 4 + 2) * NUP;
                        const bf16* rb = e == 0 ? EB + (size_t)(pm * 4 + 0) * NUP : EB + (size_t)(pm * 4 + 3) * NUP;
                        const bf16* rc = e == 0 ? EB + (size_t)(pm * 4 + 1) * NUP : EB + (size_t)((pm + 1) * 4 + 0) * NUP;
                        for (int idx = tid; idx < 704; idx += NWAVES * 64) { const int ch = idx * 4;
                            float fa[2][4], fb[2][4], fc[2][4]; f32x4 w[2][3];
#pragma unroll
                            for (int bj = 0; bj < 2; ++bj) { v2u x;
                                x = *(const v2u*)(ra + bj * DFF + ch); fa[bj][0] = bflo(x.x); fa[bj][1] = bfhi(x.x); fa[bj][2] = bflo(x.y); fa[bj][3] = bfhi(x.y);
                                x = *(const v2u*)(rb + bj * DFF + ch); fb[bj][0] = bflo(x.x); fb[bj][1] = bfhi(x.x); fb[bj][2] = bflo(x.y); fb[bj][3] = bfhi(x.y);
                                x = *(const v2u*)(rc + bj * DFF + ch); fc[bj][0] = bflo(x.x); fc[bj][1] = bfhi(x.x); fc[bj][2] = bflo(x.y); fc[bj][3] = bfhi(x.y);
#pragma unroll
                                for (int j = 0; j < 3; ++j) w[bj][j] = *(const f32x4*)(cw + j * NUP + bj * DFF + ch); }
                            float o[4];
#pragma unroll
                            for (int k = 0; k < 4; ++k) o[k] = silu_mul(w[0][0][k] * fa[0][k] + w[0][1][k] * fb[0][k] + w[0][2][k] * fc[0][k], w[1][0][k] * fa[1][k] + w[1][1][k] * fb[1][k] + w[1][2][k] * fc[1][k]);
                            v2u ov; ov.x = pk2(o[0], o[1]); ov.y = pk2(o[2], o[3]); *(v2u*)(BIG + (size_t)row * DFF + ch) = ov; }
                    }
                asm volatile("s_waitcnt vmcnt(0)" ::: "memory"); __syncthreads();
            }
        }
        { PH_BEGIN
            pg8::Gemm g{BIG, Wdown, M, DMODEL, DFF}; pg8::StaticOrder S; S.init(M, DMODEL, G, bx);
            pg8::EpiRes<false> E{nullptr, nullptr, RES, nullptr, RES, nullptr, nullptr, nullptr};
            pg8::gemm_phase<pg8::EpiRes<false>, pg8::StaticOrder, true, true>(ldsl, g, S, E);
        }
#endif
        GSYNC(); STAMP(9);
#ifndef SKIP_P10
        { PH_BEGIN
            pg8::StaticOrder S; S.init(M, DMODEL, G, bx);
            { pg8::Gemm g{P16, Wproj, M, DMODEL, PLE}; pg8::EpiStoreBf16 E{BIG, DMODEL, nullptr, 0.f, 1 << 20};
              pg8::gemm_phase<pg8::EpiStoreBf16, pg8::StaticOrder, true, true>(ldsl, g, S, E); }
            __threadfence_block(); __syncthreads();
            { pg8::Gemm g{RES, Wgate, M, DMODEL, DMODEL}; pg8::EpiRes<false> E{nullptr, nullptr, RES, BIG, l == 0 ? A : nullptr, l == 0 ? nullptr : outp, l == 0 ? RSS_IN + M : nullptr, nullptr};
              pg8::gemm_phase<pg8::EpiRes<false>, pg8::StaticOrder, true, true>(ldsl, g, S, E); }
        }
#endif
        if (l == 0) GSYNC();
        STAMP(10);
    }
#if PROF_MASK
    if (blockIdx.x == 0) { const unsigned long long t0 = __builtin_amdgcn_s_memrealtime(); while (__builtin_amdgcn_s_memrealtime() - t0 < tacc) __builtin_amdgcn_s_sleep(8); }
#endif
}

extern "C" void kernel_launch(void* const* d_in, const int* in_sizes, int n_in, void* d_out, int out_size, void* d_ws, size_t ws_size, hipStream_t stream) {
    static int grid = 0;
    if (grid == 0) {
        if (n_in != 18 || out_size != M * DMODEL || ws_size < WS_END) { fprintf(stderr, "kernel_launch: unexpected shapes (n_in %d out %d ws %zu)\n", n_in, out_size, ws_size); grid = -1; return; }
        int dev = 0, cus = 0, per_cu = 0;
        if (hipGetDevice(&dev) != hipSuccess || hipDeviceGetAttribute(&cus, hipDeviceAttributeMultiprocessorCount, dev) != hipSuccess) { grid = -1; return; }
        if (hipFuncSetAttribute((const void*)mega_fwd, hipFuncAttributeMaxDynamicSharedMemorySize, LDS_BYTES) != hipSuccess) { fprintf(stderr, "kernel_launch: hipFuncSetAttribute failed\n"); grid = -1; return; }
        if (hipOccupancyMaxActiveBlocksPerMultiprocessor(&per_cu, (const void*)mega_fwd, NWAVES * 64, LDS_BYTES) != hipSuccess || per_cu < 1) { fprintf(stderr, "kernel_launch: occupancy query gave %d\n", per_cu); (void)hipGetLastError(); grid = -1; return; }
        grid = cus * 1;
        if ((M / (grid * NWAVES)) % 4 != 0 || M % (grid * NWAVES) != 0 || SS % (M / (grid * NWAVES)) != 0) { fprintf(stderr, "kernel_launch: unsupported CU count %d\n", cus); grid = -1; return; }
        fprintf(stderr, "kernel_launch: grid %d (per_cu %d), ws %zu\n", grid, per_cu, ws_size);
    }
    if (grid < 0) return;
    Args a{};
    for (int i = 0; i < 18; ++i) a.p[i] = d_in[i];
    a.p[18] = d_out; a.p[19] = d_ws;
    void* args[] = {&a};
    hipError_t e = hipLaunchCooperativeKernel((void*)mega_fwd, dim3(grid), dim3(NWAVES * 64), args, LDS_BYTES, stream);
    if (e != hipSuccess) fprintf(stderr, "kernel_launch: cooperative launch failed: %s (grid %d)\n", hipGetErrorString(e), grid);
}
```

```cpp
#include <hip/hip_runtime.h>
#include <hip/hip_cooperative_groups.h>
#include <cstdio>
#include <cstdint>
namespace cg = cooperative_groups;
#ifndef PROF_MASK
#define PROF_MASK 0
#endif
namespace pg8 {
#define PG8_LAS __attribute__((address_space(3)))
typedef unsigned short bf16_t;
typedef short bf16x8 __attribute__((ext_vector_type(8)));
typedef float f32x4 __attribute__((ext_vector_type(4)));
typedef unsigned u32x4 __attribute__((ext_vector_type(4)));
constexpr int BM = 256, BK = 64, HALF = 128, HTB = HALF * BK * 2  , STAGE_BYTES = 8 * HTB, NXCD = 8, WGM = 8;

__host__ __device__ __forceinline__ int lds_byte(int r, int c) { const int st = (r >> 4) * 2 + (c >> 5), rr = r & 15, cc = c & 31, ob = rr * 64 + cc * 2; return st * 1024 + (ob ^ (((ob >> 9) & 1) << 5)); }
__host__ __device__ __forceinline__ void stage_rc(int b, int& R, int& C) { const int st = b / 1024, sb = b % 1024, swz = sb ^ (((sb >> 9) & 1) << 5); R = (st >> 1) * 16 + swz / 64; C = (st & 1) * 32 + (swz % 64) / 2; }
__host__ __device__ __forceinline__ int perm32(int rho) { const int n = rho >> 4, i = rho & 15; return 8 * (i >> 2) + 4 * n + (i & 3); }

struct Unit { int pm, pn; };
struct Gemm { const bf16_t* A; const bf16_t* Bt; int M, N, K; };

struct StaticOrder {
    int nM, nN, nwg, G, c;
    __host__ __device__ __forceinline__ void init(int M, int N, int G_, int c_) { nM = M / BM; nN = N / BM; nwg = nM * nN; G = G_; c = c_; }
    __host__ __device__ __forceinline__ bool next(int i, Unit& u) const {
        const long L = (long)i * G + c; if (L >= nwg) return false;
        int wgid = (int)L; { const int q = nwg / NXCD, r = nwg % NXCD, xcd = wgid % NXCD, off = wgid / NXCD; wgid = (xcd < r ? xcd * (q + 1) : r * (q + 1) + (xcd - r) * q) + off; }
        const int nig = WGM * nN, gid = wgid / nig, fm = gid * WGM, gsz = (nM - fm) < WGM ? (nM - fm) : WGM;
        u.pm = fm + ((wgid % nig) % gsz); u.pn = (wgid % nig) / gsz; return true;
    }
    __device__ __forceinline__ void a_ready(const Unit&) const {}
    __device__ __forceinline__ void done(const Unit&) const {}
};

__device__ __forceinline__ unsigned cvt_pk_bf16(float lo, float hi) { unsigned r; asm volatile("v_cvt_pk_bf16_f32 %0, %1, %2" : "=v"(r) : "v"(lo), "v"(hi)); return r; }
typedef float f32x2 __attribute__((ext_vector_type(2)));

typedef unsigned u32x2 __attribute__((ext_vector_type(2)));
__device__ __forceinline__ float bf_lo(unsigned w) { return __uint_as_float(w << 16); }
__device__ __forceinline__ float bf_hi(unsigned w) { return __uint_as_float(w & 0xffff0000u); }
__device__ __forceinline__ float dpp_ror1(float x)  { return __int_as_float(__builtin_amdgcn_update_dpp(0, __float_as_int(x), 0x121, 0xf, 0xf, false)); }
__device__ __forceinline__ float dpp_ror15(float x) { return __int_as_float(__builtin_amdgcn_update_dpp(0, __float_as_int(x), 0x12f, 0xf, 0xf, false)); }
__device__ __forceinline__ float dpp_shr1(float old, float x) { return __int_as_float(__builtin_amdgcn_update_dpp(__float_as_int(old), __float_as_int(x), 0x111, 0xf, 0xf, false)); }
__device__ __forceinline__ float dpp_shl1(float old, float x) { return __int_as_float(__builtin_amdgcn_update_dpp(__float_as_int(old), __float_as_int(x), 0x101, 0xf, 0xf, false)); }


__device__ __forceinline__ float rstd_row(const float* rss, int row, float inv_n) { return rsqrtf(rss[row] * inv_n + 1e-6f); }
struct EpiStoreBf16 {
    static constexpr bool PERM = true, AFTER_DRAIN = false, MIDK = false;
    bf16_t* O; int ldc; const float* rss; float inv_n; int prod_pn;
    __device__ __forceinline__ void operator()(const f32x4 (&acc)[2][2][4][2], const Unit& u, int wr, int wc, int fr, int fq) const {
        const int row0 = u.pm * BM + wr * 64 + fr;
        if (u.pn >= prod_pn) {
            const int col0 = prod_pn * BM + (u.pn - prod_pn) * HALF + wc * 32 + 8 * fq;
#pragma unroll
            for (int ai = 0; ai < 2; ++ai)
#pragma unroll
                for (int m = 0; m < 4; ++m) { const int row = row0 + ai * HALF + m * 16; const float s = rss ? rstd_row(rss, row, inv_n) : 1.f; const float s2 = s * s;
                    const f32x4 v0 = acc[ai][0][m][0] * acc[ai][1][m][0] * s2, v1 = acc[ai][0][m][1] * acc[ai][1][m][1] * s2;
                    u32x4 w; w.x = cvt_pk_bf16(v0[0], v0[1]); w.y = cvt_pk_bf16(v0[2], v0[3]); w.z = cvt_pk_bf16(v1[0], v1[1]); w.w = cvt_pk_bf16(v1[2], v1[3]);
                    *(u32x4*)(O + (size_t)row * ldc + col0) = w; }
            return;
        }
        const int col0 = u.pn * BM + wc * 32 + 8 * fq;
#pragma unroll
        for (int ai = 0; ai < 2; ++ai)
#pragma unroll
            for (int m = 0; m < 4; ++m) { const int row = row0 + ai * HALF + m * 16; bf16_t* rowp = O + (size_t)row * ldc + col0;
                const float s = rss ? rstd_row(rss, row, inv_n) : 1.f;
#pragma unroll
                for (int bj = 0; bj < 2; ++bj) { const f32x4 v0 = acc[ai][bj][m][0] * s, v1 = acc[ai][bj][m][1] * s;
                    u32x4 w; w.x = cvt_pk_bf16(v0[0], v0[1]); w.y = cvt_pk_bf16(v0[2], v0[3]); w.z = cvt_pk_bf16(v1[0], v1[1]); w.w = cvt_pk_bf16(v1[2], v1[3]);
                    *(u32x4*)(rowp + bj * HALF) = w; } }
    }
};
template <bool MIDK_> struct EpiRes {
    static constexpr bool PERM = true, AFTER_DRAIN = false, MIDK = MIDK_; static constexpr int MIDK_T = 8;
    const float* xlo; const float* xhi; const bf16_t* hbase; const bf16_t* pp; bf16_t* hout; float* fout; float* rss; const float* mrss;
    __device__ __forceinline__ void mid(f32x4 (&acc)[2][2][4][2], const Unit& u, int wr, int wc, int fr, int fq) const {
        int z = 0; asm volatile("" : "+v"(z));
        const int rbase = u.pm * BM + wr * 64 + fr + z;
#pragma unroll
        for (int ai = 0; ai < 2; ++ai)
#pragma unroll
            for (int m = 0; m < 4; ++m) { const float s = rstd_row(mrss, rbase + ai * HALF + m * 16, 1.f / 512.f);
#pragma unroll
                for (int bj = 0; bj < 2; ++bj)
#pragma unroll
                    for (int n = 0; n < 2; ++n) acc[ai][bj][m][n] = acc[ai][bj][m][n] * s; }
    }
    __device__ __forceinline__ void operator()(const f32x4 (&acc)[2][2][4][2], const Unit& u, int wr, int wc, int fr, int fq) const {
        const float* xb = (u.pm < 64) ? xlo : xhi;
        const int col0 = u.pn * BM + wc * 32 + 8 * fq;
#pragma unroll
        for (int ai = 0; ai < 2; ++ai) { float ssm[4];
#pragma unroll
            for (int m = 0; m < 4; ++m) { const int row = u.pm * BM + ai * HALF + wr * 64 + m * 16 + fr; const size_t off = (size_t)row * 1024 + col0;
                float ss = 0.f;
#pragma unroll
                for (int bj = 0; bj < 2; ++bj) {
                    float b[8], v[8];
                    if (xlo) { const f32x4 b0 = *(const f32x4*)(xb + off + bj * HALF), b1 = *(const f32x4*)(xb + off + bj * HALF + 4);
                        b[0] = b0[0]; b[1] = b0[1]; b[2] = b0[2]; b[3] = b0[3]; b[4] = b1[0]; b[5] = b1[1]; b[6] = b1[2]; b[7] = b1[3]; }
                    else { const u32x4 w = *(const u32x4*)(hbase + off + bj * HALF);
                        b[0] = bf_lo(w.x); b[1] = bf_hi(w.x); b[2] = bf_lo(w.y); b[3] = bf_hi(w.y); b[4] = bf_lo(w.z); b[5] = bf_hi(w.z); b[6] = bf_lo(w.w); b[7] = bf_hi(w.w); }
#pragma unroll
                    for (int i = 0; i < 4; ++i) { v[i] = acc[ai][bj][m][0][i]; v[4 + i] = acc[ai][bj][m][1][i]; }
                    if (pp) { const u32x4 w = *(const u32x4*)(pp + off + bj * HALF);
                        const float p[8] = {bf_lo(w.x), bf_hi(w.x), bf_lo(w.y), bf_hi(w.y), bf_lo(w.z), bf_hi(w.z), bf_lo(w.w), bf_hi(w.w)};
#pragma unroll
                        for (int i = 0; i < 8; ++i) v[i] = p[i] * __builtin_amdgcn_rcpf(1.f + __builtin_amdgcn_exp2f(-1.4426950408889634f * v[i])); }
#pragma unroll
                    for (int i = 0; i < 8; ++i) v[i] += b[i];
                    if (hout) { u32x4 w; w.x = cvt_pk_bf16(v[0], v[1]); w.y = cvt_pk_bf16(v[2], v[3]); w.z = cvt_pk_bf16(v[4], v[5]); w.w = cvt_pk_bf16(v[6], v[7]);
                        *(u32x4*)(hout + off + bj * HALF) = w;
                        if (rss) { const float r[8] = {bf_lo(w.x), bf_hi(w.x), bf_lo(w.y), bf_hi(w.y), bf_lo(w.z), bf_hi(w.z), bf_lo(w.w), bf_hi(w.w)};
#pragma unroll
                            for (int i = 0; i < 8; ++i) ss += r[i] * r[i]; } }
                    if (fout) { *(f32x4*)(fout + off + bj * HALF) = (f32x4){v[0], v[1], v[2], v[3]}; *(f32x4*)(fout + off + bj * HALF + 4) = (f32x4){v[4], v[5], v[6], v[7]}; }
                }
                if (rss) { ss += __shfl_xor(ss, 16); ss += __shfl_xor(ss, 32); } ssm[m] = ss;
                asm volatile("" ::: "memory"); }
            if (rss) { const float mine = fq == 0 ? ssm[0] : fq == 1 ? ssm[1] : fq == 2 ? ssm[2] : ssm[3];
                __hip_atomic_fetch_add(rss + u.pm * BM + ai * HALF + wr * 64 + 16 * fq + fr, mine, __ATOMIC_RELAXED, __HIP_MEMORY_SCOPE_AGENT); } }
    }
};
struct EpiConvAct {
    static constexpr bool PERM = true, AFTER_DRAIN = false, MIDK = false;
    bf16_t* act; bf16_t* E; const float* cw; PG8_LAS float* H; const float* rss;
    __device__ __forceinline__ void operator()(const f32x4 (&acc)[2][2][4][2], const Unit& u, int wr, int wc, int fr, int fq) const {
        const int ch0 = u.pn * 128 + wc * 32 + 8 * fq;
        float s[2][4];
#pragma unroll
        for (int ai = 0; ai < 2; ++ai)
#pragma unroll
            for (int m = 0; m < 4; ++m) s[ai][m] = rstd_row(rss, u.pm * BM + ai * HALF + wr * 64 + m * 16 + fr, 1.f / 1024.f);
#pragma unroll
        for (int ai = 0; ai < 2; ++ai) { const int seg = 2 * ai + wr;
            if (fr == 0)  { PG8_LAS f32x4* h = (PG8_LAS f32x4*)(H + ((((seg * 2 + 0) * 4 + wc) * 4 + fq) * 16)); const float q = s[ai][0]; h[0] = acc[ai][0][0][0] * q; h[1] = acc[ai][0][0][1] * q; h[2] = acc[ai][1][0][0] * q; h[3] = acc[ai][1][0][1] * q; }
            if (fr == 15) { PG8_LAS f32x4* h = (PG8_LAS f32x4*)(H + ((((seg * 2 + 1) * 4 + wc) * 4 + fq) * 16)); const float q = s[ai][3]; h[0] = acc[ai][0][3][0] * q; h[1] = acc[ai][0][3][1] * q; h[2] = acc[ai][1][3][0] * q; h[3] = acc[ai][1][3][1] * q; } }
        asm volatile("s_waitcnt lgkmcnt(0)" ::: "memory"); __builtin_amdgcn_s_barrier(); asm volatile("" ::: "memory");
#pragma unroll
        for (int n = 0; n < 2; ++n) {
            f32x4 w[2][3];
#pragma unroll
            for (int bj = 0; bj < 2; ++bj)
#pragma unroll
                for (int j = 0; j < 3; ++j) w[bj][j] = *(const f32x4*)(cw + j * 5632 + bj * 2816 + ch0 + 4 * n);
#pragma unroll
            for (int ai = 0; ai < 2; ++ai) { const int seg = 2 * ai + wr;
                f32x4 hp[2], hn[2];
                { const int sp = seg > 0 ? seg - 1 : 0; const PG8_LAS f32x4* h = (const PG8_LAS f32x4*)(H + ((((sp * 2 + 1) * 4 + wc) * 4 + fq) * 16)); hp[0] = h[n]; hp[1] = h[2 + n];
                  if (seg == 0) { hp[0] = (f32x4){0.f, 0.f, 0.f, 0.f}; hp[1] = hp[0]; } }
                { const int sn = seg < 3 ? seg + 1 : 3; const PG8_LAS f32x4* h = (const PG8_LAS f32x4*)(H + ((((sn * 2 + 0) * 4 + wc) * 4 + fq) * 16)); hn[0] = h[n]; hn[1] = h[2 + n];
                  if (seg == 3) { hn[0] = (f32x4){0.f, 0.f, 0.f, 0.f}; hn[1] = hn[0]; } }
                float cv[4][2][4];
#pragma unroll
                for (int bj = 0; bj < 2; ++bj)
#pragma unroll
                    for (int i = 0; i < 4; ++i) {
                        float sv[4];
#pragma unroll
                        for (int m = 0; m < 4; ++m) sv[m] = acc[ai][bj][m][n][i] * s[ai][m];
#pragma unroll
                        for (int m = 0; m < 4; ++m) {
                            const float X = (m > 0) ? dpp_ror1(sv[m > 0 ? m - 1 : 0]) : hp[bj][i];
                            const float Y = (m < 3) ? dpp_ror15(sv[m < 3 ? m + 1 : 3]) : hn[bj][i];
                            const float prv = dpp_shr1(X, sv[m]), nxt = dpp_shl1(Y, sv[m]);
                            cv[m][bj][i] = w[bj][0][i] * prv + w[bj][1][i] * sv[m] + w[bj][2][i] * nxt; }
                    }
#pragma unroll
                for (int m = 0; m < 4; ++m) {
                    float o[4];
#pragma unroll
                    for (int i = 0; i < 4; ++i) o[i] = cv[m][0][i] * __builtin_amdgcn_rcpf(1.f + __builtin_amdgcn_exp2f(-1.4426950408889634f * cv[m][0][i])) * cv[m][1][i];
                    u32x2 pw; pw.x = cvt_pk_bf16(o[0], o[1]); pw.y = cvt_pk_bf16(o[2], o[3]);
                    *(u32x2*)(act + (size_t)(u.pm * BM + ai * HALF + wr * 64 + m * 16 + fr) * 2816 + ch0 + 4 * n) = pw;
                }
            }
            if (wr == 0 && fr < 2) {
#pragma unroll
                for (int bj = 0; bj < 2; ++bj) { const f32x4 v = acc[0][bj][0][n] * s[0][0]; u32x2 pw; pw.x = cvt_pk_bf16(v[0], v[1]); pw.y = cvt_pk_bf16(v[2], v[3]);
                    *(u32x2*)(E + (size_t)(u.pm * 4 + fr) * 5632 + bj * 2816 + ch0 + 4 * n) = pw; } }
            if (wr == 1 && fr >= 14) {
#pragma unroll
                for (int bj = 0; bj < 2; ++bj) { const f32x4 v = acc[1][bj][3][n] * s[1][3]; u32x2 pw; pw.x = cvt_pk_bf16(v[0], v[1]); pw.y = cvt_pk_bf16(v[2], v[3]);
                    *(u32x2*)(E + (size_t)(u.pm * 4 + fr - 12) * 5632 + bj * 2816 + ch0 + 4 * n) = pw; } }
        }
    }
};
template <class Epi, class Sched, bool ALIGN_EPI = false, bool SP2 = false>
__device__ __forceinline__ void gemm_phase(PG8_LAS unsigned char* lds, const Gemm g, const Sched& S, const Epi& E) {
    int tid_ = threadIdx.x; asm volatile("" : "+v"(tid_));
    const int tid = tid_, wid = __builtin_amdgcn_readfirstlane(tid >> 6), lane = tid & 63, wr = wid >> 2, wc = wid & 3, fr = lane & 15, fq = lane >> 4;
    const int K = g.K, nt = K / BK;
    unsigned voffA[2], voffB[2];
#pragma unroll
    for (int i = 0; i < 2; ++i) { int R, C; stage_rc(tid * 16 + i * 8192, R, C); const int Rb = Epi::PERM ? ((R & ~31) + perm32(R & 31)) : R;
        voffA[i] = (unsigned)(R * K + C) * 2u; voffB[i] = (unsigned)(Rb * K + C) * 2u; }
    const size_t kstep = (size_t)(BK * 2);
    const size_t hstep = (size_t)HALF * K * 2;
    const size_t tstep = 2 * hstep;
    const unsigned ldsw = (unsigned)wid * 1024u;
    const int aoff = lds_byte(wr * 64 + fr, fq * 8), boff = lds_byte(wc * 32 + fr, fq * 8);
#define PG8_SA(b, h) (((b) * 2 + (h)) * HTB)
#define PG8_SB(b, h) ((4 + (b) * 2 + (h)) * HTB)
#define PG8_STAGE(bufoff, gbase, voff) do { _Pragma("unroll") for (int _i = 0; _i < 2; ++_i) \
        __builtin_amdgcn_global_load_lds((const unsigned*)((const char*)(gbase) + (voff)[_i]), (PG8_LAS unsigned*)(lds + (bufoff) + ldsw + _i * 8192), 16, 0, 0); } while (0)
#define PG8_LDA(dst, b, h) do { _Pragma("unroll") for (int m = 0; m < 4; ++m) _Pragma("unroll") for (int k = 0; k < 2; ++k) dst[m][k] = *(const PG8_LAS bf16x8*)(lds + PG8_SA(b, h) + aoff + m * 2048 + k * 1024); } while (0)
#define PG8_LDB(dst, b, h) do { _Pragma("unroll") for (int n = 0; n < 2; ++n) _Pragma("unroll") for (int k = 0; k < 2; ++k) dst[n][k] = *(const PG8_LAS bf16x8*)(lds + PG8_SB(b, h) + boff + n * 2048 + k * 1024); } while (0)
#define PG8_MMA(ai, bj, At, Bt) do { __builtin_amdgcn_s_setprio(1); _Pragma("unroll") for (int m = 0; m < 4; ++m) _Pragma("unroll") for (int n = 0; n < 2; ++n) _Pragma("unroll") for (int k = 0; k < 2; ++k) \
        acc[ai][bj][m][n] = __builtin_amdgcn_mfma_f32_16x16x32_bf16(Bt[n][k], At[m][k], acc[ai][bj][m][n], 0, 0, 0); __builtin_amdgcn_s_setprio(0); } while (0)
#define PG8_WAIT_V(n) asm volatile("s_waitcnt vmcnt(" #n ")" ::: "memory")
#define PG8_WAIT_L(n) asm volatile("s_waitcnt lgkmcnt(" #n ")" ::: "memory")
#define PG8_BAR __builtin_amdgcn_s_barrier()
#define PG8_SCHED __builtin_amdgcn_sched_barrier(0)
    Unit cur, nxt; int ui = 0;
    if (!S.next(0, cur)) return;
    f32x4 acc[2][2][4][2];
#pragma unroll
    for (int a = 0; a < 2; ++a)
#pragma unroll
        for (int b = 0; b < 2; ++b)
#pragma unroll
            for (int m = 0; m < 4; ++m)
#pragma unroll
                for (int n = 0; n < 2; ++n) acc[a][b][m][n] = (f32x4){0.f, 0.f, 0.f, 0.f};
    bf16x8 At[4][2], B0[2][2], B1[2][2];
    const char* cA = (const char*)g.A + (size_t)cur.pm * tstep; const char* cB = (const char*)g.Bt + (size_t)cur.pn * tstep;
    S.a_ready(cur);
    if constexpr (SP2) {
        PG8_STAGE(PG8_SB(0, 0), cB, voffB); PG8_STAGE(PG8_SB(0, 1), cB + hstep, voffB); PG8_STAGE(PG8_SA(0, 0), cA, voffA); PG8_STAGE(PG8_SA(0, 1), cA + hstep, voffA);
        if (wr == 1) PG8_BAR;
        PG8_WAIT_V(2); PG8_BAR;
        PG8_STAGE(PG8_SB(1, 0), cB + kstep, voffB); PG8_STAGE(PG8_SA(1, 0), cA + kstep, voffA); PG8_STAGE(PG8_SB(1, 1), cB + hstep + kstep, voffB);
        PG8_WAIT_V(6); PG8_BAR;
    } else {
        PG8_STAGE(PG8_SB(0, 0), cB, voffB); PG8_STAGE(PG8_SA(0, 0), cA, voffA); PG8_STAGE(PG8_SB(0, 1), cB + hstep, voffB); PG8_STAGE(PG8_SA(0, 1), cA + hstep, voffA);
        if (wr == 1) PG8_BAR;
        PG8_WAIT_V(4); PG8_BAR;
        PG8_STAGE(PG8_SB(1, 0), cB + kstep, voffB); PG8_STAGE(PG8_SA(1, 0), cA + kstep, voffA); PG8_STAGE(PG8_SB(1, 1), cB + hstep + kstep, voffB);
        PG8_WAIT_V(6); PG8_BAR;
    }
    for (;;) {
        const bool has_next = S.next(ui + 1, nxt);
        const char* nA = has_next ? (const char*)g.A + (size_t)nxt.pm * tstep : cA; const char* nB = has_next ? (const char*)g.Bt + (size_t)nxt.pn * tstep : cB;
        for (int t = 0; t < nt; t += 2) {
            if constexpr (Epi::MIDK) { if (t == Epi::MIDK_T) E.mid(acc, cur, wr, wc, fr, fq); }
            const bool last = (t == nt - 2);
            const char* a1 = cA + (size_t)(t + 1) * kstep;
            const char* a2 = last ? nA : cA + (size_t)(t + 2) * kstep; const char* b2 = last ? nB : cB + (size_t)(t + 2) * kstep;
            const char* a3 = a2 + kstep; const char* b3 = b2 + kstep;
            if (last && has_next) S.a_ready(nxt);
            if constexpr (SP2) {
            PG8_LDB(B0, 0, 0); PG8_LDB(B1, 0, 1); PG8_SCHED; PG8_LDA(At, 0, 0); PG8_STAGE(PG8_SA(1, 1), a1 + hstep, voffA);
            PG8_WAIT_V(8); PG8_WAIT_L(0); PG8_BAR; PG8_MMA(0, 0, At, B0); PG8_MMA(0, 1, At, B1); PG8_BAR; PG8_SCHED;
            PG8_LDA(At, 0, 1); PG8_STAGE(PG8_SB(0, 0), b2, voffB); PG8_STAGE(PG8_SB(0, 1), b2 + hstep, voffB); PG8_STAGE(PG8_SA(0, 0), a2, voffA);
            PG8_WAIT_V(8); PG8_WAIT_L(0); PG8_BAR; PG8_MMA(1, 0, At, B0); PG8_MMA(1, 1, At, B1); PG8_BAR; PG8_SCHED;
            PG8_LDB(B0, 1, 0); PG8_LDB(B1, 1, 1); PG8_SCHED; PG8_LDA(At, 1, 0); PG8_STAGE(PG8_SA(0, 1), a2 + hstep, voffA);
            PG8_WAIT_V(8); PG8_WAIT_L(0); PG8_BAR; PG8_MMA(0, 0, At, B0); PG8_MMA(0, 1, At, B1); PG8_BAR; PG8_SCHED;
            PG8_LDA(At, 1, 1); PG8_STAGE(PG8_SB(1, 0), b3, voffB); PG8_STAGE(PG8_SB(1, 1), b3 + hstep, voffB); PG8_STAGE(PG8_SA(1, 0), a3, voffA);
            PG8_WAIT_V(8); PG8_WAIT_L(0); PG8_BAR; PG8_MMA(1, 0, At, B0); PG8_MMA(1, 1, At, B1); PG8_BAR; PG8_SCHED;
            } else {
            PG8_LDB(B0, 0, 0); PG8_SCHED; PG8_LDA(At, 0, 0); PG8_STAGE(PG8_SA(1, 1), a1 + hstep, voffA);
            PG8_WAIT_L(8); PG8_BAR; PG8_WAIT_L(0); PG8_MMA(0, 0, At, B0); PG8_BAR; PG8_SCHED;
            PG8_LDB(B1, 0, 1); PG8_STAGE(PG8_SB(0, 0), b2, voffB);
            PG8_BAR; PG8_WAIT_L(0); PG8_MMA(0, 1, At, B1); PG8_BAR;
            PG8_LDA(At, 0, 1); PG8_STAGE(PG8_SA(0, 0), a2, voffA);
            PG8_BAR; PG8_WAIT_L(0); PG8_MMA(1, 0, At, B0); PG8_BAR; PG8_SCHED;
            PG8_STAGE(PG8_SB(0, 1), b2 + hstep, voffB);
            PG8_WAIT_V(6); PG8_BAR; PG8_MMA(1, 1, At, B1); PG8_BAR;
            PG8_LDB(B0, 1, 0); PG8_SCHED; PG8_LDA(At, 1, 0); PG8_STAGE(PG8_SA(0, 1), a2 + hstep, voffA);
            PG8_WAIT_L(8); PG8_BAR; PG8_WAIT_L(0); PG8_MMA(0, 0, At, B0); PG8_BAR; PG8_SCHED;
            PG8_LDB(B1, 1, 1); PG8_STAGE(PG8_SB(1, 0), b3, voffB);
            PG8_BAR; PG8_WAIT_L(0); PG8_MMA(0, 1, At, B1); PG8_BAR;
            PG8_LDA(At, 1, 1); PG8_STAGE(PG8_SA(1, 0), a3, voffA);
            PG8_BAR; PG8_WAIT_L(0); PG8_MMA(1, 0, At, B0); PG8_BAR; PG8_SCHED;
            PG8_STAGE(PG8_SB(1, 1), b3 + hstep, voffB);
            PG8_WAIT_V(6); PG8_BAR; PG8_MMA(1, 1, At, B1); PG8_BAR;
            }
        }
        if constexpr (ALIGN_EPI) { if (wr == 0) PG8_BAR; }
        if constexpr (!Epi::AFTER_DRAIN) { E(acc, cur, wr, wc, fr, fq); S.done(cur); }
        if (!has_next) break;
#pragma unroll
        for (int a = 0; a < 2; ++a)
#pragma unroll
            for (int b = 0; b < 2; ++b)
#pragma unroll
                for (int m = 0; m < 4; ++m)
#pragma unroll
                    for (int n = 0; n < 2; ++n) acc[a][b][m][n] = (f32x4){0.f, 0.f, 0.f, 0.f};
        cur = nxt; cA = nA; cB = nB; ++ui;
        if constexpr (ALIGN_EPI) { if (wr == 1) PG8_BAR; }
    }
    PG8_WAIT_V(0);
    if constexpr (!ALIGN_EPI) { if (wr == 0) PG8_BAR; }
    PG8_BAR;
    if constexpr (Epi::AFTER_DRAIN) { E.fused(acc, cur, wr, wc, fr, fq, lds, wid, lane); S.done(cur); }
#undef PG8_SA
#undef PG8_SB
#undef PG8_STAGE
#undef PG8_LDA
#undef PG8_LDB
#undef PG8_MMA
#undef PG8_WAIT_V
#undef PG8_WAIT_L
#undef PG8_BAR
#undef PG8_SCHED
}
}
#include <hip/hip_bf16.h>
#include <cmath>
namespace attn_body {
using bf16=__hip_bfloat16;
using bf16x8=__attribute__((ext_vector_type(8)))short;
using s16x4=__attribute__((ext_vector_type(4)))short;
using f32x16=__attribute__((ext_vector_type(16)))float;
using u32x4=__attribute__((ext_vector_type(4)))unsigned;
constexpr int D=64,ZP=1792,OP=1024;
constexpr int NW=8,QBLK=32,QB=QBLK*NW,KVBLK=64;
__device__ __forceinline__ int crow(int r,int hi){return (r&3)+8*(r>>2)+4*hi;}
#define SBAR() __builtin_amdgcn_sched_barrier(0)
__device__ __forceinline__ void cmask(f32x16&p0,f32x16&p1,int jb,int qrel,int hi){
  const float NEG=-INFINITY; int kb=64*jb+4*hi;
  #pragma unroll
  for(int r=0;r<16;++r){int kv=kb+(r&3)+8*(r>>2); if(kv>qrel)p0[r]=NEG; if(kv+32>qrel)p1[r]=NEG;}
}

constexpr int NSLOT=3, SLOTB=8192;
constexpr int LDS_K=0, LDS_V=NSLOT*SLOTB, LDS_WS=2*NSLOT*SLOTB, LDS_OST=LDS_WS+NW*64*4, LDS_BYTES=LDS_OST+NW*4096;
constexpr float C2=0.125f*1.4426950408889634f;
__device__ __forceinline__ void glds16(const void*gsrc,unsigned lds_dst){unsigned keep;
  asm volatile("s_mov_b32 %0, m0\n\ts_mov_b32 m0, %2\n\ts_nop 0\n\tglobal_load_lds_dwordx4 %1, off\n\ts_mov_b32 m0, %0":"=&s"(keep):"v"(gsrc),"s"(lds_dst):"memory");}
__device__ __forceinline__ float max3f(float a,float b,float c){float r;asm("v_max3_f32 %0, %1, %2, %3":"=v"(r):"v"(a),"v"(b),"v"(c));return r;}
__device__ __forceinline__ float max2f(float a,float b){float r;asm("v_max_f32_e32 %0, %1, %2":"=v"(r):"v"(a),"v"(b));return r;}
__device__ __forceinline__ float fadd_s(float a,float b){float r;asm("v_add_f32_e32 %0, %1, %2":"=v"(r):"v"(a),"v"(b));return r;}
__device__ __forceinline__ float fsub_s(float a,float b){float r;asm("v_sub_f32_e32 %0, %1, %2":"=v"(r):"v"(a),"v"(b));return r;}
typedef float f32x2_t __attribute__((ext_vector_type(2))); typedef __bf16 bf16x2_t __attribute__((ext_vector_type(2)));
__device__ __forceinline__ unsigned cvtpk_s(float lo,float hi){f32x2_t v={lo,hi};bf16x2_t b=__builtin_convertvector(v,bf16x2_t);return __builtin_bit_cast(unsigned,b);}
#define WAIT_BAR(N) asm volatile("s_waitcnt vmcnt(" #N ") lgkmcnt(0)\n\ts_barrier":::"memory")

__device__ __forceinline__ void qkt(f32x16&p0,f32x16&p1,const char*Kslot,const bf16x8*qr,const f32x16&negm,int r32,int hi){
  const char*kb=Kslot+hi*1024+r32*16;
  #pragma unroll
  for(int d0=0;d0<4;++d0){
    const bf16x8 b0=*reinterpret_cast<const bf16x8*>(kb+d0*2048);
    const bf16x8 b1=*reinterpret_cast<const bf16x8*>(kb+d0*2048+512);
    if(d0==0){p0=__builtin_amdgcn_mfma_f32_32x32x16_bf16(b0,qr[0],negm,0,0,0);p1=__builtin_amdgcn_mfma_f32_32x32x16_bf16(b1,qr[0],negm,0,0,0);}
    else{p0=__builtin_amdgcn_mfma_f32_32x32x16_bf16(b0,qr[d0],p0,0,0,0);p1=__builtin_amdgcn_mfma_f32_32x32x16_bf16(b1,qr[d0],p1,0,0,0);}}
}
typedef __attribute__((address_space(3))) const char* lds_cptr;
typedef short v4i16_t __attribute__((ext_vector_type(4)));
__device__ __forceinline__ void kload8(bf16x8*kf,lds_cptr kp){
  kf[0]=*(const __attribute__((address_space(3))) bf16x8*)(kp);      kf[1]=*(const __attribute__((address_space(3))) bf16x8*)(kp+512);
  kf[2]=*(const __attribute__((address_space(3))) bf16x8*)(kp+2048); kf[3]=*(const __attribute__((address_space(3))) bf16x8*)(kp+2560);
  kf[4]=*(const __attribute__((address_space(3))) bf16x8*)(kp+4096); kf[5]=*(const __attribute__((address_space(3))) bf16x8*)(kp+4608);
  kf[6]=*(const __attribute__((address_space(3))) bf16x8*)(kp+6144); kf[7]=*(const __attribute__((address_space(3))) bf16x8*)(kp+6656);
}
__device__ __forceinline__ void kload2(bf16x8*kf,lds_cptr kp,int j){ kf[2*j]=*(const __attribute__((address_space(3))) bf16x8*)(kp+j*2048); kf[2*j+1]=*(const __attribute__((address_space(3))) bf16x8*)(kp+j*2048+512); }
__device__ __forceinline__ s16x4 vtr(lds_cptr p){ return __builtin_bit_cast(s16x4,__builtin_amdgcn_ds_read_tr16_b64_v4i16((__attribute__((address_space(3))) v4i16_t*)p)); }
__device__ __forceinline__ float rowmax(const f32x16&p0,const f32x16&p1){
  float a=max3f(p0[0],p0[1],p1[0]),b=max3f(p0[2],p0[3],p1[1]);a=max3f(a,p1[2],p1[3]);
  #pragma unroll
  for(int r=4;r<16;r+=4){a=max3f(a,p0[r],p0[r+1]);b=max3f(b,p0[r+2],p0[r+3]);a=max3f(a,p1[r],p1[r+1]);b=max3f(b,p1[r+2],p1[r+3]);}
  const float m=max2f(a,b);
  auto rr=__builtin_amdgcn_permlane32_swap(__float_as_uint(m),__float_as_uint(m),false,false);
  return max2f(__uint_as_float(rr[0]),__uint_as_float(rr[1]));
}
__device__ __forceinline__ void pv(f32x16*o,int vb,bf16x8 pa0,bf16x8 pa1,bf16x8 pa2,bf16x8 pa3){
  #pragma unroll
  for(int d0=0;d0<2;++d0){s16x4 lo[4],hi[4];
    #pragma unroll
    for(int ks=0;ks<4;++ks){
      asm volatile("ds_read_b64_tr_b16 %0,%1 offset:%c2":"=&v"(lo[ks]):"v"(vb),"i"(d0*4096+ks*1024):"memory");
      asm volatile("ds_read_b64_tr_b16 %0,%1 offset:%c2":"=&v"(hi[ks]):"v"(vb),"i"(d0*4096+ks*1024+512):"memory");}
    asm volatile("s_waitcnt lgkmcnt(0)":::"memory");SBAR();
    #define PK(k) (bf16x8){lo[k][0],lo[k][1],lo[k][2],lo[k][3],hi[k][0],hi[k][1],hi[k][2],hi[k][3]}
    o[d0]=__builtin_amdgcn_mfma_f32_32x32x16_bf16(pa0,PK(0),o[d0],0,0,0);
    o[d0]=__builtin_amdgcn_mfma_f32_32x32x16_bf16(pa1,PK(1),o[d0],0,0,0);
    o[d0]=__builtin_amdgcn_mfma_f32_32x32x16_bf16(pa2,PK(2),o[d0],0,0,0);
    o[d0]=__builtin_amdgcn_mfma_f32_32x32x16_bf16(pa3,PK(3),o[d0],0,0,0);
    #undef PK
  }
}

#ifndef ATTN_STORE16
#define ATTN_STORE16(p,v) (*(u32x4*)(p)=(v))
#endif
template<int THRL> __device__ __forceinline__ void attn_unit(long rowbase,int S,int h,int qb,const bf16*__restrict__ Z,bf16*O,float*rss,const float*__restrict__ qg,const float*__restrict__ rope,char*shm){
  int tid_=threadIdx.x; asm volatile("":"+v"(tid_)); const int tid=tid_,lane=tid&63,r32=lane&31,hi=lane>>5; const int wid=__builtin_amdgcn_readfirstlane(tid>>6);
  const int q0=qb*QB;
  const bf16*Qw=Z+(rowbase+q0+wid*QBLK)*ZP+h*D;
  const bf16*Kh=Z+rowbase*ZP+512+(h>>2)*D,*Vh=Z+rowbase*ZP+640+(h>>2)*D;
  const unsigned lds0=(unsigned)(uintptr_t)shm;
  float*wsf=(float*)(shm+LDS_WS)+wid*64;
  const bf16*ksrc=Kh+(long)lane*ZP+wid*8;
  const bf16*vsrc=Vh+(long)(16*(wid&3)+(lane>>2))*ZP+(wid>>2)*32+(lane&3)*8;
  const unsigned kdst=lds0+LDS_K+wid*1024, vdst=lds0+LDS_V+wid*1024;
  #define DMA_K(t,slot) glds16(ksrc+(long)(t)*KVBLK*ZP,(unsigned)__builtin_amdgcn_readfirstlane(kdst+(slot)))
  #define DMA_V(t,slot) glds16(vsrc+(long)(t)*KVBLK*ZP,(unsigned)__builtin_amdgcn_readfirstlane(vdst+(slot)))
  const int vb0=(int)(lds0+LDS_V)+((lane>>4)&1)*32+(lane&3)*8+(4*hi+((lane&15)>>2))*64;
  const char*Kbase=shm+LDS_K; bf16x8 kf[8];
  const lds_cptr shm3=(lds_cptr)shm; const lds_cptr kp0=shm3+LDS_K+hi*1024+r32*16; const lds_cptr vp0=shm3+LDS_V+((lane>>4)&1)*32+(lane&3)*8+(4*hi+((lane&15)>>2))*64;
  const int NT=S/KVBLK;
  DMA_K(0,0);DMA_V(0,0);DMA_K(1,SLOTB);
  bf16x8 qr[4];
  #pragma unroll
  for(int d0=0;d0<4;++d0)qr[d0]=*reinterpret_cast<const bf16x8*>(&Qw[(long)r32*ZP+d0*16+hi*8]);
  float mhat=0.f,l_reg=0.f;f32x16 o[2];o[0]=f32x16{};o[1]=f32x16{};f32x16 negm=f32x16{};asm volatile("":"+v"(negm));
  const int qrel=wid*QBLK+r32;
  #define CMASK(P0,P1,t) do{}while(0)
  bool resc=false;
  #define START(P0,P1) do{ const float rm=rowmax(P0,P1); resc=false; \
    { const float dl=rm; mhat=fadd_s(mhat,dl); \
      _Pragma("unroll") for(int r=0;r<16;++r){P0[r]=fsub_s(P0[r],dl);P1[r]=fsub_s(P1[r],dl);} \
      _Pragma("unroll") for(int r=0;r<16;++r)negm[r]=-mhat; asm volatile("":"+v"(negm)); } \
    _Pragma("unroll") for(int r=0;r<16;++r)P0[r]=__builtin_amdgcn_exp2f(P0[r]); }while(0)
  #define RESC() do{ if(resc){ asm volatile("s_waitcnt lgkmcnt(0)":::"memory"); \
      _Pragma("unroll") for(int d_=0;d_<2;++d_) _Pragma("unroll") for(int r=0;r<16;++r)o[d_][r]*=wsf[crow(r,hi)]; } }while(0)
  f32x16 pA0,pA1,pB0,pB1;
  int sl_prev=0,sl_cur=0,sl_next=SLOTB;
  #define ROT() do{sl_prev=sl_cur;sl_cur=sl_next;sl_next=(sl_next==(NSLOT-1)*SLOTB)?0:sl_next+SLOTB;}while(0)
  DMA_K(2,2*SLOTB);
  {
    const int tq=q0+wid*QBLK+r32; float x[4][8]; float ss=0.f;
    #pragma unroll
    for(int d0=0;d0<4;++d0){
      #pragma unroll
      for(int j=0;j<8;++j){x[d0][j]=__uint_as_float((unsigned)(unsigned short)qr[d0][j]<<16); ss+=x[d0][j]*x[d0][j];}}
    {auto rr=__builtin_amdgcn_permlane32_swap(__float_as_uint(ss),__float_as_uint(ss),false,false); ss=__uint_as_float(rr[0])+__uint_as_float(rr[1]);}
    const float rstd=__builtin_amdgcn_rsqf(ss*(1.f/64.f)+1e-6f);
    #pragma unroll
    for(int d0=0;d0<4;++d0){
      #pragma unroll
      for(int j=0;j<8;++j)x[d0][j]*=rstd*qg[16*d0+8*hi+j];}
    const float*tr=rope+(size_t)((tq>>6)*16+8*hi)*2,*tc=rope+(size_t)((tq&63)*16+8*hi)*2;
    #pragma unroll
    for(int j=0;j<8;++j){
      const float cr=tr[2*j],sr=tr[2*j+1],cc=tc[2*j],sc=tc[2*j+1];
      const float a=x[0][j],b=x[1][j],e=x[2][j],f=x[3][j];
      x[0][j]=(a*cr-b*sr)*C2; x[1][j]=(b*cr+a*sr)*C2; x[2][j]=(e*cc-f*sc)*C2; x[3][j]=(f*cc+e*sc)*C2;}
    #pragma unroll
    for(int d0=0;d0<4;++d0){u32x4 w; w[0]=cvtpk_s(x[d0][0],x[d0][1]);w[1]=cvtpk_s(x[d0][2],x[d0][3]);w[2]=cvtpk_s(x[d0][4],x[d0][5]);w[3]=cvtpk_s(x[d0][6],x[d0][7]); qr[d0]=__builtin_bit_cast(bf16x8,w);}
  }
  WAIT_BAR(3);
  qkt(pA0,pA1,Kbase,qr,negm,r32,hi);asm volatile("s_nop 15\n\ts_nop 7":"+v"(pA0),"+v"(pA1));CMASK(pA0,pA1,0);
  START(pA0,pA1);
  _Pragma("unroll") for(int r=0;r<16;++r)pA1[r]=__builtin_amdgcn_exp2f(pA1[r]);
  WAIT_BAR(0);
  DMA_K(3,0);DMA_V(1,SLOTB);
  ROT();
  kload8(kf,kp0+sl_cur);
  WAIT_BAR(2);
  s16x4 vlo[8],vhi[8]; u32x4 pw0,pw1,pw2,pw3;
  #define PKW(P,B) cvtpk_s(P[B],P[B+1])
  #define PAF(k) __builtin_bit_cast(bf16x8,pw##k)
  #define VFR(i) (bf16x8){vlo[i][0],vlo[i][1],vlo[i][2],vlo[i][3],vhi[i][0],vhi[i][1],vhi[i][2],vhi[i][3]}
  #define PIN(x) asm volatile("":"+v"(x))
  #define MX3(a,b,c) __builtin_fmaxf(__builtin_fmaxf((a),(b)),(c))
  #define GAPA(MF,A0,A1,A2,A3,W0,W1,PW) do{ MF; sacc+=A0; sacc+=A1; sacc+=A2; sacc+=A3; PIN(sacc); W0; W1; PIN(PW); SBAR(); }while(0)
  #define EX(v) __builtin_amdgcn_exp2f(v)
  #define GAPB(MF,X,B) do{ MF; X[B]=EX(X[B]); X[B+1]=EX(X[B+1]); X[B+2]=EX(X[B+2]); X[B+3]=EX(X[B+3]); PIN(X); SBAR(); }while(0)
  #define VRD(i) do{ vlo[i]=vtr(vp_+(((i)>>2)*4096+((i)&3)*1024)); vhi[i]=vtr(vp_+(((i)>>2)*4096+((i)&3)*1024+512)); }while(0)
  #define KRD(G,j) do{ if(G){ kload2(kf,kp0+sl_next,j); SBAR(); } }while(0)
  #define STEP(C0,C1,P0,P1,t,GK,GV,GL) do{ SBAR(); \
    const lds_cptr vp_=vp0+sl_prev; \
    VRD(0); SBAR(); float sacc=(P0[0]+P0[1]); \
    GAPA(C0=__builtin_amdgcn_mfma_f32_32x32x16_bf16(kf[0],qr[0],negm,0,0,0), P0[2],P0[3],P0[4],P0[5],     pw0[0]=PKW(P0,0), pw0[1]=PKW(P0,2), pw0); \
    VRD(4); SBAR(); GAPA(C1=__builtin_amdgcn_mfma_f32_32x32x16_bf16(kf[1],qr[0],negm,0,0,0), P0[6],P0[7],P0[8],P0[9],     pw0[2]=PKW(P0,4), pw0[3]=PKW(P0,6), pw0); \
    VRD(1); SBAR(); GAPA(C0=__builtin_amdgcn_mfma_f32_32x32x16_bf16(kf[2],qr[1],C0,0,0,0),   P0[10],P0[11],P0[12],P0[13], pw1[0]=PKW(P0,8), pw1[1]=PKW(P0,10), pw1); \
    VRD(5); SBAR(); GAPA(C1=__builtin_amdgcn_mfma_f32_32x32x16_bf16(kf[3],qr[1],C1,0,0,0),   P0[14],P0[15],P1[0],P1[1],   pw1[2]=PKW(P0,12),pw1[3]=PKW(P0,14), pw1); \
    VRD(2); SBAR(); GAPA(C0=__builtin_amdgcn_mfma_f32_32x32x16_bf16(kf[4],qr[2],C0,0,0,0),   P1[2],P1[3],P1[4],P1[5],     pw2[0]=PKW(P1,0), pw2[1]=PKW(P1,2), pw2); \
    VRD(6); SBAR(); GAPA(C1=__builtin_amdgcn_mfma_f32_32x32x16_bf16(kf[5],qr[2],C1,0,0,0),   P1[6],P1[7],P1[8],P1[9],     pw2[2]=PKW(P1,4), pw2[3]=PKW(P1,6), pw2); \
    VRD(3); SBAR(); GAPA(C0=__builtin_amdgcn_mfma_f32_32x32x16_bf16(kf[6],qr[3],C0,0,0,0),   P1[10],P1[11],P1[12],P1[13], pw3[0]=PKW(P1,8), pw3[1]=PKW(P1,10), pw3); \
    VRD(7); SBAR(); GAPA(C1=__builtin_amdgcn_mfma_f32_32x32x16_bf16(kf[7],qr[3],C1,0,0,0),   P1[14],P1[15],0.f,0.f,       pw3[2]=PKW(P1,12),pw3[3]=PKW(P1,14), pw3); \
    l_reg+=sacc; \
    if(GK){DMA_K((t)+3,sl_cur);} if(GV){DMA_V((t)+1,sl_next);} \
    CMASK(C0,C1,t); \
    { float a=MX3(C0[0],C0[1],C1[0]),b=MX3(C0[2],C0[3],C1[1]); a=MX3(a,C1[2],C1[3]); \
      _Pragma("unroll") for(int r=4;r<16;r+=4){a=MX3(a,C0[r],C0[r+1]);b=MX3(b,C0[r+2],C0[r+3]);a=MX3(a,C1[r],C1[r+1]);b=MX3(b,C1[r+2],C1[r+3]);} \
      float rm=__builtin_fmaxf(a,b); { auto rr=__builtin_amdgcn_permlane32_swap(__float_as_uint(rm),__float_as_uint(rm),false,false); rm=__builtin_fmaxf(__uint_as_float(rr[0]),__uint_as_float(rr[1])); } \
      resc=false; \
      if(__builtin_expect(__any(rm>(float)THRL),0)){ const float dl=__builtin_fmaxf(rm,0.f); mhat+=dl; \
        _Pragma("unroll") for(int r=0;r<16;++r){C0[r]-=dl;C1[r]-=dl;} \
        _Pragma("unroll") for(int r=0;r<16;++r)negm[r]=-mhat; asm volatile("":"+v"(negm)); \
        const float f=__builtin_amdgcn_exp2f(-dl); l_reg*=f; if(hi==0)wsf[r32]=f; resc=true; } } \
    SBAR(); \
    GAPB(o[0]=__builtin_amdgcn_mfma_f32_32x32x16_bf16(PAF(0),VFR(0),o[0],0,0,0), C0,0); \
    GAPB(o[1]=__builtin_amdgcn_mfma_f32_32x32x16_bf16(PAF(0),VFR(4),o[1],0,0,0), C0,4); \
    KRD(GL,0); GAPB(o[0]=__builtin_amdgcn_mfma_f32_32x32x16_bf16(PAF(1),VFR(1),o[0],0,0,0), C0,8); \
    KRD(GL,1); GAPB(o[1]=__builtin_amdgcn_mfma_f32_32x32x16_bf16(PAF(1),VFR(5),o[1],0,0,0), C0,12); \
    KRD(GL,2); GAPB(o[0]=__builtin_amdgcn_mfma_f32_32x32x16_bf16(PAF(2),VFR(2),o[0],0,0,0), C1,0); \
    KRD(GL,3); GAPB(o[1]=__builtin_amdgcn_mfma_f32_32x32x16_bf16(PAF(2),VFR(6),o[1],0,0,0), C1,4); \
    GAPB(o[0]=__builtin_amdgcn_mfma_f32_32x32x16_bf16(PAF(3),VFR(3),o[0],0,0,0), C1,8); \
    GAPB(o[1]=__builtin_amdgcn_mfma_f32_32x32x16_bf16(PAF(3),VFR(7),o[1],0,0,0), C1,12); \
    }while(0)
  int t=1;
  #undef CMASK
  #define CMASK(P0,P1,t) do{}while(0)
  for(;t+5<NT;t+=2){
    STEP(pB0,pB1,pA0,pA1,t,true,true,true);     WAIT_BAR(2); RESC(); ROT();
    STEP(pA0,pA1,pB0,pB1,t+1,true,true,true);   WAIT_BAR(2); RESC(); ROT();
  }
  #undef CMASK
  #define CMASK(P0,P1,t) do{}while(0)
  #define ENDW(tt) do{ if((tt)+3<NT){WAIT_BAR(2);} else if((tt)+2<NT){WAIT_BAR(1);} else {WAIT_BAR(0);} }while(0)
  for(;t+1<NT;t+=2){
    STEP(pB0,pB1,pA0,pA1,t,(t+3<NT),(t+1<NT),(t+1<NT));       ENDW(t);   RESC(); ROT();
    STEP(pA0,pA1,pB0,pB1,t+1,(t+4<NT),(t+2<NT),(t+2<NT));     ENDW(t+1); RESC(); ROT();
  }
  STEP(pB0,pB1,pA0,pA1,NT-1,false,false,false); RESC();
  { float sacc=pB0[0]+pB0[1]; _Pragma("unroll") for(int r=2;r<16;++r)sacc+=pB0[r]; _Pragma("unroll") for(int r=0;r<16;++r)sacc+=pB1[r]; l_reg+=sacc;
    pw0=(u32x4){PKW(pB0,0),PKW(pB0,2),PKW(pB0,4),PKW(pB0,6)};pw1=(u32x4){PKW(pB0,8),PKW(pB0,10),PKW(pB0,12),PKW(pB0,14)};pw2=(u32x4){PKW(pB1,0),PKW(pB1,2),PKW(pB1,4),PKW(pB1,6)};pw3=(u32x4){PKW(pB1,8),PKW(pB1,10),PKW(pB1,12),PKW(pB1,14)};
    SBAR(); pv(o,vb0+sl_cur,PAF(0),PAF(1),PAF(2),PAF(3)); }
  #undef PKW
  #undef PAF
  #undef VFR
  #undef PIN
  #undef MX3
  #undef GAPA
  #undef GAPB
  #undef EX
  #undef VRD
  #undef KRD
  #undef STEP
  #undef ENDW
  {auto rr=__builtin_amdgcn_permlane32_swap(__float_as_uint(l_reg),__float_as_uint(l_reg),false,false);l_reg=__uint_as_float(rr[0])+__uint_as_float(rr[1]);}
  if(hi==0)wsf[32+r32]=l_reg;asm volatile("s_waitcnt lgkmcnt(0)":::"memory");
  float rli[16];
  #pragma unroll
  for(int r=0;r<16;++r)rli[r]=__builtin_amdgcn_rcpf(wsf[32+crow(r,hi)]);
  bf16*Ow=O+(rowbase+q0+wid*QBLK)*OP+h*D;
  { bf16*stg=(bf16*)(shm+LDS_OST)+wid*2048;
    #pragma unroll
    for(int r=0;r<16;++r){const int orow=crow(r,hi);
      #pragma unroll
      for(int d0=0;d0<2;++d0)stg[orow*64+d0*32+r32]=__float2bfloat16(o[d0][r]*rli[r]);}
    asm volatile("s_waitcnt lgkmcnt(0)":::"memory");
    float rs4[4];
    #pragma unroll
    for(int i=0;i<4;++i){const int row=i*8+(lane>>3),ch=lane&7; const u32x4 v=*(const u32x4*)(stg+row*64+ch*8); ATTN_STORE16(Ow+(long)row*OP+ch*8,v);
      float s=0.f;
      #pragma unroll
      for(int j=0;j<4;++j){const float lo=__uint_as_float(v[j]<<16),hh=__uint_as_float(v[j]&0xffff0000u); s+=lo*lo+hh*hh;}
      s+=__shfl_xor(s,1);s+=__shfl_xor(s,2);s+=__shfl_xor(s,4); rs4[i]=s;}
    { const int ch=lane&7;
      const float mine=ch==0?rs4[0]:ch==1?rs4[1]:ch==2?rs4[2]:rs4[3];
      if(ch<4)__hip_atomic_fetch_add(rss+rowbase+q0+wid*QBLK+ch*8+(lane>>3),mine,__ATOMIC_RELAXED,__HIP_MEMORY_SCOPE_AGENT);} }
  asm volatile("s_waitcnt lgkmcnt(0)\n\ts_barrier":::"memory");
  #undef DMA_K
  #undef DMA_V
  #undef CMASK
  #undef START
  #undef RESC
  #undef ROT
}
constexpr int ATTN_LDS_BYTES=LDS_BYTES;
#undef SBAR
#undef WAIT_BAR
}
#define LAS __attribute__((address_space(3)))
#define XB_TMO      128
#define XB_XCNT(j)  (256  + 64 * (j))
#define XB_XSUB(j)  (1280 + 64 * (j))
#define XB_XGEN(j)  (2304 + 64 * (j))
#define XB_TOP      3328
#define XB_TOPGEN   3392
#define XCD_BAR_WORDS 3456
#define XB_SPIN_CAP (1u << 18)

__device__ __forceinline__ unsigned xb_ld(unsigned* p)              { return __hip_atomic_load(p, __ATOMIC_RELAXED, __HIP_MEMORY_SCOPE_AGENT); }
__device__ __forceinline__ unsigned xb_add(unsigned* p, unsigned v) { return __hip_atomic_fetch_add(p, v, __ATOMIC_RELAXED, __HIP_MEMORY_SCOPE_AGENT); }
__device__ __forceinline__ unsigned xb_xcc_id() { return (unsigned)__builtin_amdgcn_s_getreg((3 << 11) | 20) & 0xFu; }
#define XB_SPIN(cond, bar) do { unsigned _sp = 0; while (cond) { __builtin_amdgcn_s_sleep(1); \
    if ((++_sp & 255u) == 0u) { if (xb_ld(&(bar)[XB_TMO])) break; if (_sp > XB_SPIN_CAP) { atomicAdd(&(bar)[XB_TMO], 1u); break; } } } } while (0)

struct XcdBarrier {
    unsigned* bar; unsigned x;
    volatile LAS unsigned* st;
};

__device__ __forceinline__ XcdBarrier xcd_barrier_post(unsigned* bar, volatile LAS unsigned* st) {
    XcdBarrier b; b.bar = bar; b.x = xb_xcc_id(); b.st = st;
    if (threadIdx.x == 0) (void)xb_add(&bar[XB_XCNT(b.x)], 1u);
    return b;
}
__device__ __forceinline__ void xcd_barrier_complete(unsigned* bar, unsigned x, unsigned& nloc, unsigned& nx) {
    const unsigned G = gridDim.x * gridDim.y * gridDim.z;
    unsigned sum, cnt, mine, sp = 0u;
    for (;;) {
        sum = 0u; cnt = 0u; mine = 0u;
#pragma unroll
        for (unsigned j = 0; j < 16; ++j) { const unsigned c = xb_ld(&bar[XB_XCNT(j)]); sum += c; cnt += (c > 0u) ? 1u : 0u; mine = (j == x) ? c : mine; }
        if (sum == G) break;
        __builtin_amdgcn_s_sleep(1);
        if ((++sp & 255u) == 0u) { if (xb_ld(&bar[XB_TMO])) break; if (sp > XB_SPIN_CAP) { atomicAdd(&bar[XB_TMO], 1u); break; } }
    }
    nloc = mine > 0u ? mine : 1u; nx = cnt > 0u ? cnt : 1u;
}

__device__ __forceinline__ void xcd_barrier(const XcdBarrier& b) {
    asm volatile("s_waitcnt vmcnt(0)" ::: "memory");
    __syncthreads();
    if (threadIdx.x == 0) {
        unsigned* bar = b.bar;
        __builtin_amdgcn_s_waitcnt(0);
        unsigned nloc = b.st[0], nx = b.st[1];
        if (nloc == 0u) { xcd_barrier_complete(bar, b.x, nloc, nx); b.st[0] = nloc; b.st[1] = nx; }
        const unsigned old = xb_add(&bar[XB_XSUB(b.x)], 1u);
        const unsigned gen = old / nloc;
        if (old + 1u == (gen + 1u) * nloc) {
            __builtin_amdgcn_fence(__ATOMIC_RELEASE, "agent");
            asm volatile("s_waitcnt vmcnt(0)" ::: "memory");
            const unsigned og = xb_add(&bar[XB_TOP], 1u);
            const unsigned tg = og / nx;
            if (og + 1u == (tg + 1u) * nx) xb_add(&bar[XB_TOPGEN], 1u);
            else XB_SPIN(xb_ld(&bar[XB_TOPGEN]) == tg, bar);
            __builtin_amdgcn_fence(__ATOMIC_ACQUIRE, "agent");
            xb_add(&bar[XB_XGEN(b.x)], 1u);
            asm volatile("s_waitcnt vmcnt(0)" ::: "memory");
        } else {
            XB_SPIN(xb_ld(&bar[XB_XGEN(b.x)]) == gen, bar);
            __builtin_amdgcn_fence(__ATOMIC_ACQUIRE, "agent");
            asm volatile("s_waitcnt vmcnt(0)" ::: "memory");
        }
    }
    __syncthreads();
}

constexpr int NWAVES = 8;
constexpr int M = 32768, MP = 16384, DMODEL = 1024, DIN = 2304, ZW = 1792  , DFF = 2816, NUP = 5632, PLE = 256, SP = 4096, SS = 2048;
constexpr float EPS = 1e-6f;
constexpr size_t MiB = 1u << 20;
constexpr size_t WS_ROPE = 0;
constexpr size_t WS_WIN = 1 * MiB;
constexpr size_t WS_WOUT = WS_WIN + (size_t)DIN * DMODEL * 2;
constexpr size_t WS_WUP = WS_WOUT + (size_t)DMODEL * DMODEL * 2;
constexpr size_t WS_WDOWN = WS_WUP + (size_t)NUP * DMODEL * 2;
constexpr size_t WS_WGATE = WS_WDOWN + (size_t)DMODEL * DFF * 2;
constexpr size_t WS_WPROJ = WS_WGATE + (size_t)DMODEL * DMODEL * 2;
constexpr size_t WS_RSS = 27 * MiB;
constexpr size_t WS_A = 28 * MiB;
constexpr size_t WS_BIG = 92 * MiB;
constexpr size_t WS_W2 = 268 * MiB;
constexpr size_t HB_E = 32 * MiB;
constexpr size_t WS_P16 = 274 * MiB;
constexpr size_t WS_END = 290 * MiB;
static_assert(WS_WPROJ + (size_t)DMODEL * PLE * 2 <= WS_A, "weights fit");
constexpr int RING_BYTES = 131072, MISC_OFF = RING_BYTES, HALO_OFF = RING_BYTES + 1024, LDS_BYTES = 147456;
constexpr size_t WS_CTL = 512 * 1024, CTL_BYTES = 64 * 1024;

typedef unsigned short bf16;
typedef unsigned v4u __attribute__((ext_vector_type(4)));
typedef unsigned v2u __attribute__((ext_vector_type(2)));
typedef float f32x4 __attribute__((ext_vector_type(4)));

__device__ __forceinline__ unsigned pk2(float lo, float hi) { return pg8::cvt_pk_bf16(lo, hi); }
__device__ __forceinline__ float bflo(unsigned w) { return __uint_as_float(w << 16); }
__device__ __forceinline__ float bfhi(unsigned w) { return __uint_as_float(w & 0xffff0000u); }
__device__ __forceinline__ void unpack8(const v4u v, float* f) { f[0] = bflo(v.x); f[1] = bfhi(v.x); f[2] = bflo(v.y); f[3] = bfhi(v.y); f[4] = bflo(v.z); f[5] = bfhi(v.z); f[6] = bflo(v.w); f[7] = bfhi(v.w); }
__device__ __forceinline__ v4u pack8(const float* f) { v4u o; o.x = pk2(f[0], f[1]); o.y = pk2(f[2], f[3]); o.z = pk2(f[4], f[5]); o.w = pk2(f[6], f[7]); return o; }
#define DPPF(x, ctrl) __int_as_float(__builtin_amdgcn_update_dpp(0, __float_as_int(x), (ctrl), 0xf, 0xf, false))
__device__ __forceinline__ float sum8(float v) {
    v += DPPF(v, 0xB1); v += DPPF(v, 0x4E); v += DPPF(v, 0x141); return v;
}
__device__ __forceinline__ float wave_sum(float v) {
    v = sum8(v); v += DPPF(v, 0x128);
    return __int_as_float(__builtin_amdgcn_readlane(__float_as_int(v), 0)) + __int_as_float(__builtin_amdgcn_readlane(__float_as_int(v), 16))
         + __int_as_float(__builtin_amdgcn_readlane(__float_as_int(v), 32)) + __int_as_float(__builtin_amdgcn_readlane(__float_as_int(v), 48));
}
struct Args { void* p[20]; };

struct TItem { const float* W; bf16* WT; const float* ks; int K, N, mode, kmax, item; };
__device__ __forceinline__ void titem_load(const TItem& t, f32x4 (&v)[8], int lane) {
    const int nblk = t.N / 32, kb = t.item / nblk, nb = t.item % nblk, k0 = 64 * kb, n0 = 32 * nb;
#pragma unroll
    for (int i = 0; i < 8; ++i) { const int kk = 8 * i + (lane >> 3), nq = (lane & 7) * 4; v[i] = __builtin_nontemporal_load((const f32x4*)(t.W + (size_t)(k0 + kk) * t.N + n0 + nq)); }
}
__device__ __forceinline__ void titem_finish(const TItem& t, f32x4 (&v)[8], float* scr, int lane) {
    const int nblk = t.N / 32, kb = t.item / nblk, nb = t.item % nblk, k0 = 64 * kb, n0 = 32 * nb;
#pragma unroll
    for (int i = 0; i < 8; ++i) { const int kk = 8 * i + (lane >> 3), nq = (lane & 7) * 4; f32x4 x = v[i];
        if (t.ks && k0 + kk < t.kmax) x = x * t.ks[k0 + kk];
        float* d = scr + kk * 33 + nq; d[0] = x.x; d[1] = x.y; d[2] = x.z; d[3] = x.w; }
    __builtin_amdgcn_s_waitcnt(0xc07f); asm volatile("" ::: "memory");
    int r0 = n0;
    if (t.mode == 1) { r0 = (n0 < DFF) ? 256 * (n0 / 128) + n0 % 128 : 256 * ((n0 - DFF) / 128) + 128 + (n0 - DFF) % 128; }
    if (t.mode == 2 && n0 >= 1280) { r0 = (n0 < 1792) ? 1280 + 256 * ((n0 - 1280) / 128) + (n0 - 1280) % 128 : 1280 + 256 * ((n0 - 1792) / 128) + 128 + (n0 - 1792) % 128; }
    const int c = lane & 7;
#pragma unroll
    for (int j = 0; j < 4; ++j) { const int n = (lane >> 3) + 8 * j; const float* s = scr + (8 * c) * 33 + n;
        v4u o; o.x = pk2(s[0 * 33], s[1 * 33]); o.y = pk2(s[2 * 33], s[3 * 33]); o.z = pk2(s[4 * 33], s[5 * 33]); o.w = pk2(s[6 * 33], s[7 * 33]);
        *(v4u*)(t.WT + (size_t)(r0 + n) * t.K + k0 + 8 * c) = o; }
    __builtin_amdgcn_s_waitcnt(0xc07f); asm volatile("" ::: "memory");
}
__device__ __forceinline__ void transpose_matrix(const float* W, int K, int N, bf16* WT, int mode, const float* ks, int kmax, float* scr, int start, int stride, int lane) {
    const int npairs = (K / 64) * (N / 32) / 2;
    for (int p = start; p < npairs; p += stride) {
        TItem t0{W, WT, ks, K, N, mode, kmax, 2 * p}; TItem t1 = t0; t1.item = 2 * p + 1;
        f32x4 v0[8], v1[8];
        titem_load(t0, v0, lane); titem_load(t1, v1, lane);
        titem_finish(t0, v0, scr, lane);
        titem_finish(t1, v1, scr, lane);
    }
}
__device__ __forceinline__ void xrow_load(const float* xrow, f32x4 (&v)[4], int lane) {
    const f32x4* xr = (const f32x4*)xrow + lane;
#pragma unroll
    for (int j = 0; j < 4; ++j) v[j] = __builtin_nontemporal_load(xr + 64 * j);
}
__device__ __forceinline__ void xrow_finish(const f32x4 (&v)[4], bf16* orow, float* rss, int lane) {
    v2u* o8 = (v2u*)orow + lane; float s = 0.f;
#pragma unroll
    for (int j = 0; j < 4; ++j) { v2u o; o.x = pk2(v[j].x, v[j].y); o.y = pk2(v[j].z, v[j].w); o8[64 * j] = o;
        const float a = bflo(o.x), b = bfhi(o.x), c = bflo(o.y), d = bfhi(o.y); s += (a * a + b * b) + (c * c + d * d); }
    s = wave_sum(s); if (lane == 0) *rss = s;
}
__device__ __forceinline__ void prow_cvt(const float* pr, bf16* orow, int lane) {
    const f32x4 pv = __builtin_nontemporal_load((const f32x4*)pr + lane); v2u o; o.x = pk2(pv.x, pv.y); o.y = pk2(pv.z, pv.w); ((v2u*)orow)[lane] = o;
}
constexpr float ATT_C2 = 0.125f * 1.4426950408889634f;
struct MixIn { v4u k, gb, gu[3]; f32x4 rp[4]; };
struct MixPar { float kg[8], cw[3][8], cog[8]; };
__device__ __forceinline__ void mix_par(MixPar& p, const float* kg, const float* cw, const float* cog, int lane) {
    const int c = lane & 7, ch = lane * 8;
#pragma unroll
    for (int j = 0; j < 8; ++j) { p.kg[j] = kg[c * 8 + j]; p.cog[j] = cog[ch + j]; p.cw[0][j] = cw[ch + j]; p.cw[1][j] = cw[512 + ch + j]; p.cw[2][j] = cw[1024 + ch + j]; }
}
__device__ __forceinline__ void mix_load(int row, const bf16* Z, const float* rope, MixIn& r, int lane) {
    const int S = row < MP ? SP : SS, t = row & (S - 1);
    const bf16* zr = Z + (size_t)row * ZW; const int ch = lane * 8;
    r.k = *(const v4u*)(zr + 512 + (lane & 15) * 8);
    r.gb = *(const v4u*)(zr + 768 + ch); r.gu[1] = *(const v4u*)(zr + 1280 + ch);
    const v4u z4 = {0u, 0u, 0u, 0u};
    if (t > 0) r.gu[0] = *(const v4u*)(zr - ZW + 1280 + ch); else r.gu[0] = z4;
    if (t < S - 1) r.gu[2] = *(const v4u*)(zr + ZW + 1280 + ch); else r.gu[2] = z4;
    const int c = lane & 7, pos = (c >> 2) ? (t & 63) : (t >> 6);
    const f32x4* rp = (const f32x4*)(rope + (size_t)(pos * 16 + (c & 1) * 8) * 2);
#pragma unroll
    for (int j = 0; j < 4; ++j) r.rp[j] = rp[j];
}
struct RowX { v4u k, gb; f32x4 rp[4]; };
__device__ __forceinline__ void rowx_load(int row, const bf16* Z, const float* rope, RowX& r, int lane) {
    const int S = row < MP ? SP : SS, t = row & (S - 1);
    const bf16* zr = Z + (size_t)row * ZW;
    r.k = *(const v4u*)(zr + 512 + (lane & 15) * 8); r.gb = *(const v4u*)(zr + 768 + lane * 8);
    const int c = lane & 7, pos = (c >> 2) ? (t & 63) : (t >> 6);
    const f32x4* rp = (const f32x4*)(rope + (size_t)(pos * 16 + (c & 1) * 8) * 2);
#pragma unroll
    for (int j = 0; j < 4; ++j) r.rp[j] = rp[j];
}
__device__ __forceinline__ v4u gu_load(int row, bool valid, const bf16* Z, int lane) {
    const v4u z4 = {0u, 0u, 0u, 0u};
    return valid ? *(const v4u*)(Z + (size_t)row * ZW + 1280 + lane * 8) : z4;
}
__device__ __forceinline__ void mix_finish(int row, const MixIn& r, const MixPar& P, bf16* Z, bf16* MIX, int lane);
__device__ __forceinline__ void mix_finish_w(int row, const v4u gm, const v4u g0, const v4u gp, const RowX& x, const MixPar& P, bf16* Z, bf16* MIX, int lane) {
    MixIn r; r.k = x.k; r.gb = x.gb; r.gu[0] = gm; r.gu[1] = g0; r.gu[2] = gp;
#pragma unroll
    for (int j = 0; j < 4; ++j) r.rp[j] = x.rp[j];
    mix_finish(row, r, P, Z, MIX, lane);
}
__device__ __forceinline__ void mix_finish(int row, const MixIn& r, const MixPar& P, bf16* Z, bf16* MIX, int lane) {
    bf16* zr = Z + (size_t)row * ZW;
    const int c = lane & 7;
    float cs[8], sn[8];
#pragma unroll
    for (int j = 0; j < 4; ++j) { cs[2 * j] = r.rp[j].x; sn[2 * j] = r.rp[j].y; cs[2 * j + 1] = r.rp[j].z; sn[2 * j + 1] = r.rp[j].w; }
    const float sgn = (c & 2) ? 1.f : -1.f;
    {
        bf16* p = zr + 512 + (lane & 15) * 8;
        float v[8]; unpack8(r.k, v);
        float ss = 0.f;
#pragma unroll
        for (int j = 0; j < 8; ++j) ss += v[j] * v[j];
        const float rstd = rsqrtf(sum8(ss) * (1.f / 64.f) + EPS);
        float o[8];
#pragma unroll
        for (int j = 0; j < 8; ++j) v[j] = v[j] * rstd * P.kg[j];
#pragma unroll
        for (int j = 0; j < 8; ++j) { const float pr = DPPF(v[j], 0x4E); o[j] = v[j] * cs[j] + sgn * pr * sn[j]; }
        if (lane < 16) *(v4u*)p = pack8(o);
    }
    {
        const int ch = lane * 8;
        float gb[8], a[8], acc[8];
        unpack8(r.gb, gb);
#pragma unroll
        for (int j = 0; j < 8; ++j) acc[j] = 0.f;
#pragma unroll
        for (int d = 0; d < 3; ++d) { unpack8(r.gu[d], a);
#pragma unroll
            for (int j = 0; j < 8; ++j) acc[j] += P.cw[d][j] * a[j]; }
        float ss = 0.f;
#pragma unroll
        for (int j = 0; j < 8; ++j) { acc[j] *= gb[j]; ss += acc[j] * acc[j]; }
        const float rstd = rsqrtf(wave_sum(ss) * (1.f / 512.f) + EPS);
#pragma unroll
        for (int j = 0; j < 8; ++j) acc[j] = acc[j] * rstd * P.cog[j];
        *(v4u*)(MIX + (size_t)row * DMODEL + 512 + ch) = pack8(acc);
    }
}
__device__ __forceinline__ float silu_mul(float g, float u) { return g * __builtin_amdgcn_rcpf(1.f + __builtin_amdgcn_exp2f(-1.4426950408889634f * g)) * u; }

__global__ void __launch_bounds__(NWAVES * 64, 2) mega_fwd(Args a) {
    extern __shared__ __attribute__((aligned(16))) unsigned char lds[];
    cg::grid_group grid = cg::this_grid();
    if (threadIdx.x < 64) ((LAS unsigned*)((LAS unsigned char*)lds + MISC_OFF))[threadIdx.x] = 0u;
    __syncthreads();
    if (blockIdx.x == 0) { unsigned* cw = (unsigned*)((unsigned char*)a.p[19] + WS_CTL); for (int i = threadIdx.x; i < XCD_BAR_WORDS; i += NWAVES * 64) cw[i] = 0u; }
    XcdBarrier bar; bar.bar = (unsigned*)((unsigned char*)a.p[19] + WS_CTL); bar.x = 0; bar.st = (volatile LAS unsigned*)((LAS unsigned char*)lds + MISC_OFF);
#define GSYNC() xcd_barrier(bar)
#define PH_BEGIN \
    int tid_ = threadIdx.x; asm volatile("" : "+v"(tid_)); int zi = 0; asm volatile("" : "+s"(zi)); \
    const int tid = tid_, lane = tid & 63, wave = __builtin_amdgcn_readfirstlane(tid >> 6); \
    const int G = gridDim.x + zi, bx = blockIdx.x + zi; \
    const int vcu = (G % 8 == 0) ? (bx % 8) * (G / 8) + bx / 8 : bx; \
    const int gw = vcu * NWAVES + wave, NGW = G * NWAVES; \
    unsigned char* ws = (unsigned char*)a.p[19 + zi]; float* outp = (float*)a.p[18 + zi]; \
    float* rope = (float*)(ws + WS_ROPE); \
    float* RSS_IN = (float*)(ws + WS_RSS); float* RSS_FFN = RSS_IN + 2 * M; float* RSS_ATT = RSS_IN + 4 * M; \
    bf16* HA = (bf16*)outp; unsigned char* HBb = (unsigned char*)outp + (size_t)M * DMODEL * 2; bf16* A = (bf16*)(ws + WS_A); \
    unsigned char* wb = (l == 0) ? ws + WS_WIN : HBb;                        \
    bf16* Win = (bf16*)wb; bf16* Wout = (bf16*)(wb + (WS_WOUT - WS_WIN)); bf16* Wup = (bf16*)(wb + (WS_WUP - WS_WIN)); bf16* Wdown = (bf16*)(wb + (WS_WDOWN - WS_WIN)); \
    bf16* Wgate = (bf16*)(l == 0 ? ws + WS_WGATE : ws + WS_W2); bf16* Wproj = Wgate + (size_t)DMODEL * DMODEL; \
    bf16* RES = (l == 0) ? HA : A;  bf16* MIX = (l == 0) ? A : HA;            \
    bf16* BIG = (bf16*)(ws + WS_BIG); bf16* EB = (bf16*)(HBb + HB_E); bf16* P16 = (bf16*)(ws + WS_P16); \
    LAS unsigned char* ldsl = (LAS unsigned char*)lds; \
    (void)tid; (void)lane; (void)wave; (void)vcu; (void)gw; (void)NGW; (void)rope; (void)Win; (void)Wout; (void)Wup; (void)Wdown; (void)Wgate; (void)Wproj; (void)A; (void)BIG; (void)EB; (void)P16; (void)ldsl; (void)outp; (void)RSS_IN; (void)RSS_FFN; (void)RSS_ATT; (void)HA; (void)RES; (void)MIX;
#define IN(k) ((const float*)a.p[(k) + zi])
#if PROF_MASK
    unsigned long long tprev = __builtin_amdgcn_s_memrealtime(), tacc = 0;
#define STAMP(k) do { const unsigned long long tn_ = __builtin_amdgcn_s_memrealtime(); if ((PROF_MASK >> (k)) & 1) tacc += tn_ - tprev; tprev = tn_; } while (0)
#else
#define STAMP(k) do {} while (0)
#endif
#pragma unroll 1
    for (int l = 0; l < 2; ++l) {
        if (l == 0) {
#ifndef SKIP_P0
        { PH_BEGIN
            float* scr = (float*)(lds + wave * 16384);
            constexpr int I_IN = (DMODEL / 64) * (DIN / 32), I_OUT = (DMODEL / 64) * (DMODEL / 32), I_UP = (DMODEL / 64) * (NUP / 32), I_DOWN = (DFF / 64) * (DMODEL / 32), I_GATE = I_OUT, I_PROJ = (PLE / 64) * (DMODEL / 32);
            int cum = 0;
#pragma unroll 1
            for (int ly = 0; ly < 2; ++ly) {
                unsigned char* wb_ = ly == 0 ? ws + WS_WIN : HBb; bf16* wg_ = (bf16*)(ly == 0 ? ws + WS_WGATE : ws + WS_W2);
                transpose_matrix(IN(5) + (size_t)ly * DMODEL * DIN, DMODEL, DIN, (bf16*)wb_, 2, IN(4) + ly * DMODEL, DMODEL, scr, (gw + NGW - cum % NGW) % NGW, NGW, lane); cum += I_IN / 2;
                transpose_matrix(IN(11) + (size_t)ly * DMODEL * DMODEL, DMODEL, DMODEL, (bf16*)(wb_ + (WS_WOUT - WS_WIN)), 0, IN(9) + ly * 512, 512, scr, (gw + NGW - cum % NGW) % NGW, NGW, lane); cum += I_OUT / 2;
                transpose_matrix(IN(13) + (size_t)ly * DMODEL * NUP, DMODEL, NUP, (bf16*)(wb_ + (WS_WUP - WS_WIN)), 1, IN(12) + ly * DMODEL, DMODEL, scr, (gw + NGW - cum % NGW) % NGW, NGW, lane); cum += I_UP / 2;
                transpose_matrix(IN(15) + (size_t)ly * DFF * DMODEL, DFF, DMODEL, (bf16*)(wb_ + (WS_WDOWN - WS_WIN)), 0, nullptr, 0, scr, (gw + NGW - cum % NGW) % NGW, NGW, lane); cum += I_DOWN / 2;
                transpose_matrix(IN(16) + (size_t)ly * DMODEL * DMODEL, DMODEL, DMODEL, wg_, 0, nullptr, 0, scr, (gw + NGW - cum % NGW) % NGW, NGW, lane); cum += I_GATE / 2;
                transpose_matrix(IN(17) + (size_t)ly * PLE * DMODEL, PLE, DMODEL, wg_ + (size_t)DMODEL * DMODEL, 0, nullptr, 0, scr, (gw + NGW - cum % NGW) % NGW, NGW, lane); cum += I_PROJ / 2;
            }
            const float* xp = IN(0); const float* xs = IN(1); const float* pp_ = IN(2); const float* ps_ = IN(3);
            for (int m = gw; m < M; m += 4 * NGW) {
                f32x4 v[4][4];
#pragma unroll
                for (int q = 0; q < 4; ++q) { const int mm = m + q * NGW; xrow_load(mm < MP ? xp + (size_t)mm * DMODEL : xs + (size_t)(mm - MP) * DMODEL, v[q], lane); }
#pragma unroll
                for (int q = 0; q < 4; ++q) { const int mm = m + q * NGW; prow_cvt(mm < MP ? pp_ + (size_t)mm * PLE : ps_ + (size_t)(mm - MP) * PLE, P16 + (size_t)mm * PLE, lane); }
#pragma unroll
                for (int q = 0; q < 4; ++q) { const int mm = m + q * NGW; xrow_finish(v[q], HA + (size_t)mm * DMODEL, RSS_IN + mm, lane); }
            }
            { const int gt = bx * (NWAVES * 64) + tid;
                for (int i = gt; i < 5 * M; i += G * NWAVES * 64) RSS_IN[M + i] = 0.f;
                if (gt < 1024) { const int pos = gt >> 4, j = gt & 15; const float fr = __builtin_amdgcn_exp2f(-(float)j * 0.8304820237218406f); const float ang = (float)pos * fr;
                    const float rev = ang * 0.15915494309189535f; rope[2 * gt] = __builtin_amdgcn_cosf(rev); rope[2 * gt + 1] = __builtin_amdgcn_sinf(rev); } }
        }
#endif
        grid.sync();
        bar = xcd_barrier_post((unsigned*)((unsigned char*)a.p[19] + WS_CTL), (volatile LAS unsigned*)((LAS unsigned char*)lds + MISC_OFF));
        STAMP(0);
        }
#ifndef SKIP_P1
        { PH_BEGIN
            pg8::Gemm g{RES, Win, M, DIN, DMODEL}; pg8::StaticOrder S; S.init(M, DIN, G, bx);
            pg8::EpiStoreBf16 E{BIG, ZW, RSS_IN + (size_t)l * M, 1.f / 1024.f, 5};
            pg8::gemm_phase<pg8::EpiStoreBf16, pg8::StaticOrder, true, true>(ldsl, g, S, E);
        }
#endif
        GSYNC(); STAMP(1);
#ifndef SKIP_P2
        { PH_BEGIN
            const float* kg = IN(7) + l * 64; const float* cw = IN(8) + l * 3 * 512; const float* cog = IN(10) + l * 512;
            MixPar P; mix_par(P, kg, cw, cog, lane);
            {
                const int rpw = M / NGW, r0 = gw * rpw, S = r0 < MP ? SP : SS;
                v4u gm = gu_load(r0 - 1, (r0 & (S - 1)) != 0, BIG, lane), g0 = gu_load(r0, true, BIG, lane), g1 = gu_load(r0 + 1, true, BIG, lane), g2 = gu_load(r0 + 2, true, BIG, lane);
                RowX x0, x1; rowx_load(r0, BIG, rope, x0, lane); rowx_load(r0 + 1, BIG, rope, x1, lane);
#pragma unroll 1
                for (int i = 0; i < rpw; i += 2) { const int r = r0 + i; const bool more = i + 2 < rpw;
                    v4u n1 = g1, n2 = g2; RowX nx0 = x0, nx1 = x1;
                    if (more) { n1 = gu_load(r + 3, true, BIG, lane); n2 = gu_load(r + 4, ((r + 4) & (S - 1)) != 0, BIG, lane); rowx_load(r + 2, BIG, rope, nx0, lane); rowx_load(r + 3, BIG, rope, nx1, lane); }
                    mix_finish_w(r, gm, g0, g1, x0, P, BIG, MIX, lane); mix_finish_w(r + 1, g0, g1, g2, x1, P, BIG, MIX, lane);
                    gm = g1; g0 = g2; g1 = n1; g2 = n2; x0 = nx0; x1 = nx1; }
            }
        }
#endif
        GSYNC(); STAMP(2);
#ifndef SKIP_P3
        { PH_BEGIN
            const float* qg = IN(6) + l * 64;
            const int u0 = (int)(((long)vcu * 512) / G), u1 = (int)(((long)(vcu + 1) * 512) / G);
            for (int u = u0; u < u1; ++u) { const int bh = u >> 4, qb = u & 15; attn_body::attn_unit<8>((long)(bh >> 3) * SP, SP, bh & 7, qb, (const attn_body::bf16*)BIG, (attn_body::bf16*)MIX, RSS_ATT + (size_t)l * M, qg, rope, (char*)lds); }
            for (int u = u0; u < u1; ++u) { const int bh = u >> 3, qb = u & 7; attn_body::attn_unit<8>((long)MP + (long)(bh >> 3) * SS, SS, bh & 7, qb, (const attn_body::bf16*)BIG, (attn_body::bf16*)MIX, RSS_ATT + (size_t)l * M, qg, rope, (char*)lds); }
        }
#endif
        GSYNC(); STAMP(3);
#ifndef SKIP_P5
        { PH_BEGIN
            pg8::Gemm g{MIX, Wout, M, DMODEL, DMODEL}; pg8::StaticOrder S; S.init(M, DMODEL, G, bx);
            pg8::EpiRes<true> E{nullptr, nullptr, RES, nullptr, RES, nullptr, RSS_FFN + (size_t)l * M, RSS_ATT + (size_t)l * M};
            pg8::gemm_phase<pg8::EpiRes<true>, pg8::StaticOrder, true, true>(ldsl, g, S, E);
        }
#endif
        GSYNC(); STAMP(5);
#ifndef SKIP_P7
        { PH_BEGIN
            pg8::Gemm g{RES, Wup, M, NUP, DMODEL}; pg8::StaticOrder S; S.init(M, NUP, G, bx);
            pg8::EpiConvAct E{BIG, EB, IN(14) + (size_t)l * 3 * NUP, (LAS float*)(ldsl + HALO_OFF), RSS_FFN + (size_t)l * M};
            pg8::gemm_phase<pg8::EpiConvAct, pg8::StaticOrder, true, true>(ldsl, g, S, E);
        }
#endif
        GSYNC(); STAMP(7);
#ifndef SKIP_P9
        { PH_BEGIN
            pg8::StaticOrder S; S.init(M, DMODEL, G, bx);
            if (l == 1) { const float* pp_ = IN(2) + (size_t)MP * PLE; const float* ps_ = IN(3) + (size_t)MP * PLE;
                for (int m = gw; m < M; m += NGW) prow_cvt(m < MP ? pp_ + (size_t)m * PLE : ps_ + (size_t)(m - MP) * PLE, P16 + (size_t)m * PLE, lane); }
            {
                const float* cw = IN(14) + (size_t)l * 3 * NUP; pg8::Unit u;
                for (int i = 0; S.next(i, u); ++i)
#pragma unroll 1
                    for (int e = 0; e < 2; ++e) {
                        const int pm = u.pm, per = pm < 64 ? 16 : 8, ps = pm < 64 ? pm : pm - 64;
                        if (e == 0 ? (ps % per == 0) : (ps % per == per - 1)) continue;
                        const int row = e == 0 ? pm * 256 : pm * 256 + 255;
                        const bf16* ra = e == 0 ? EB + (size_t)((pm - 1) * 4 + 3) * NUP : EB + (size_t)(pm * 4 + 2) * NUP;
                        const bf16* rb = e == 0 ? EB + (size_t)(pm * 4 + 0) * NUP : EB + (size_t)(pm * 4 + 3) * NUP;
                        const bf16* rc = e == 0 ? EB + (size_t)(pm * 4 + 1) * NUP : EB + (size_t)((pm + 1) * 4 + 0) * NUP;
                        for (int idx = tid; idx < 704; idx += NWAVES * 64) { const int ch = idx * 4;
                            float fa[2][4], fb[2][4], fc[2][4]; f32x4 w[2][3];
#pragma unroll
                            for (int bj = 0; bj < 2; ++bj) { v2u x;
                                x = *(const v2u*)(ra + bj * DFF + ch); fa[bj][0] = bflo(x.x); fa[bj][1] = bfhi(x.x); fa[bj][2] = bflo(x.y); fa[bj][3] = bfhi(x.y);
                                x = *(const v2u*)(rb + bj * DFF + ch); fb[bj][0] = bflo(x.x); fb[bj][1] = bfhi(x.x); fb[bj][2] = bflo(x.y); fb[bj][3] = bfhi(x.y);
                                x = *(const v2u*)(rc + bj * DFF + ch); fc[bj][0] = bflo(x.x); fc[bj][1] = bfhi(x.x); fc[bj][2] = bflo(x.y); fc[bj][3] = bfhi(x.y);
#pragma unroll
                                for (int j = 0; j < 3; ++j) w[bj][j] = *(const f32x4*)(cw + j * NUP + bj * DFF + ch); }
                            float o[4];
#pragma unroll
                            for (int k = 0; k < 4; ++k) o[k] = silu_mul(w[0][0][k] * fa[0][k] + w[0][1][k] * fb[0][k] + w[0][2][k] * fc[0][k], w[1][0][k] * fa[1][k] + w[1][1][k] * fb[1][k] + w[1][2][k] * fc[1][k]);
                            v2u ov; ov.x = pk2(o[0], o[1]); ov.y = pk2(o[2], o[3]); *(v2u*)(BIG + (size_t)row * DFF + ch) = ov; }
                    }
                asm volatile("s_waitcnt vmcnt(0)" ::: "memory"); __syncthreads();
            }
        }
        { PH_BEGIN
            pg8::Gemm g{BIG, Wdown, M, DMODEL, DFF}; pg8::StaticOrder S; S.init(M, DMODEL, G, bx);
            pg8::EpiRes<false> E{nullptr, nullptr, RES, nullptr, RES, nullptr, nullptr, nullptr};
            pg8::gemm_phase<pg8::EpiRes<false>, pg8::StaticOrder, true, true>(ldsl, g, S, E);
        }
#endif
        GSYNC(); STAMP(9);
#ifndef SKIP_P10
        { PH_BEGIN
            pg8::StaticOrder S; S.init(M, DMODEL, G, bx);
            { pg8::Gemm g{P16, Wproj, M, DMODEL, PLE}; pg8::EpiStoreBf16 E{BIG, DMODEL, nullptr, 0.f, 1 << 20};
              pg8::gemm_phase<pg8::EpiStoreBf16, pg8::StaticOrder, true, true>(ldsl, g, S, E); }
            __threadfence_block(); __syncthreads();
            { pg8::Gemm g{RES, Wgate, M, DMODEL, DMODEL}; pg8::EpiRes<false> E{nullptr, nullptr, RES, BIG, l == 0 ? A : nullptr, l == 0 ? nullptr : outp, l == 0 ? RSS_IN + M : nullptr, nullptr};
              pg8::gemm_phase<pg8::EpiRes<false>, pg8::StaticOrder, true, true>(ldsl, g, S, E); }
        }
#endif
        if (l == 0) GSYNC();
        STAMP(10);
    }
#if PROF_MASK
    if (blockIdx.x == 0) { const unsigned long long t0 = __builtin_amdgcn_s_memrealtime(); while (__builtin_amdgcn_s_memrealtime() - t0 < tacc) __builtin_amdgcn_s_sleep(8); }
#endif
}

extern "C" void kernel_launch(void* const* d_in, const int* in_sizes, int n_in, void* d_out, int out_size, void* d_ws, size_t ws_size, hipStream_t stream) {
    static int grid = 0;
    if (grid == 0) {
        if (n_in != 18 || out_size != M * DMODEL || ws_size < WS_END) { fprintf(stderr, "kernel_launch: unexpected shapes (n_in %d out %d ws %zu)\n", n_in, out_size, ws_size); grid = -1; return; }
        int dev = 0, cus = 0, per_cu = 0;
        if (hipGetDevice(&dev) != hipSuccess || hipDeviceGetAttribute(&cus, hipDeviceAttributeMultiprocessorCount, dev) != hipSuccess) { grid = -1; return; }
        if (hipFuncSetAttribute((const void*)mega_fwd, hipFuncAttributeMaxDynamicSharedMemorySize, LDS_BYTES) != hipSuccess) { fprintf(stderr, "kernel_launch: hipFuncSetAttribute failed\n"); grid = -1; return; }
        if (hipOccupancyMaxActiveBlocksPerMultiprocessor(&per_cu, (const void*)mega_fwd, NWAVES * 64, LDS_BYTES) != hipSuccess || per_cu < 1) { fprintf(stderr, "kernel_launch: occupancy query gave %d\n", per_cu); (void)hipGetLastError(); grid = -1; return; }
        grid = cus * 1;
        if ((M / (grid * NWAVES)) % 4 != 0 || M % (grid * NWAVES) != 0 || SS % (M / (grid * NWAVES)) != 0) { fprintf(stderr, "kernel_launch: unsupported CU count %d\n", cus); grid = -1; return; }
        fprintf(stderr, "kernel_launch: grid %d (per_cu %d), ws %zu\n", grid, per_cu, ws_size);
    }
    if (grid < 0) return;
    Args a{};
    for (int i = 0; i < 18; ++i) a.p[i] = d_in[i];
    a.p[18] = d_out; a.p[19] = d_ws;
    void* args[] = {&a};
    hipError_t e = hipLaunchCooperativeKernel((void*)mega_fwd, dim3(grid), dim3(NWAVES * 64), args, LDS_BYTES, stream);
    if (e != hipSuccess) fprintf(stderr, "kernel_launch: cooperative launch failed: %s (grid %d)\n", hipGetErrorString(e), grid);
}
```

```cpp
#include <hip/hip_runtime.h>
#include <hip/hip_cooperative_groups.h>
#include <cstdio>
#include <cstdint>
namespace cg = cooperative_groups;
#ifndef PROF_MASK
#define PROF_MASK 0
#endif
namespace pg8 {
#define PG8_LAS __attribute__((address_space(3)))
typedef unsigned short bf16_t;
typedef short bf16x8 __attribute__((ext_vector_type(8)));
typedef float f32x4 __attribute__((ext_vector_type(4)));
typedef unsigned u32x4 __attribute__((ext_vector_type(4)));
constexpr int BM = 256, BK = 64, HALF = 128, HTB = HALF * BK * 2  , STAGE_BYTES = 8 * HTB, NXCD = 8, WGM = 8;

__host__ __device__ __forceinline__ int lds_byte(int r, int c) { const int st = (r >> 4) * 2 + (c >> 5), rr = r & 15, cc = c & 31, ob = rr * 64 + cc * 2; return st * 1024 + (ob ^ (((ob >> 9) & 1) << 5)); }
__host__ __device__ __forceinline__ void stage_rc(int b, int& R, int& C) { const int st = b / 1024, sb = b % 1024, swz = sb ^ (((sb >> 9) & 1) << 5); R = (st >> 1) * 16 + swz / 64; C = (st & 1) * 32 + (swz % 64) / 2; }
__host__ __device__ __forceinline__ int perm32(int rho) { const int n = rho >> 4, i = rho & 15; return 8 * (i >> 2) + 4 * n + (i & 3); }

struct Unit { int pm, pn; };
struct Gemm { const bf16_t* A; const bf16_t* Bt; int M, N, K; };

struct StaticOrder {
    int nM, nN, nwg, G, c, rev = 0;
    __host__ __device__ __forceinline__ void init(int M, int N, int G_, int c_) { nM = M / BM; nN = N / BM; nwg = nM * nN; G = G_; c = c_; }
    __host__ __device__ __forceinline__ bool next(int i, Unit& u) const {
        const long L = (long)i * G + c; if (L >= nwg) return false;
        int wgid = (int)L; { const int q = nwg / NXCD, r = nwg % NXCD, xcd = wgid % NXCD, off = wgid / NXCD; wgid = (xcd < r ? xcd * (q + 1) : r * (q + 1) + (xcd - r) * q) + off; }
        const int nig = WGM * nN, gid = wgid / nig, fm = gid * WGM, gsz = (nM - fm) < WGM ? (nM - fm) : WGM;
        u.pm = fm + ((wgid % nig) % gsz); u.pn = (wgid % nig) / gsz; if (rev) u.pm = nM - 1 - u.pm; return true;
    }
    __device__ __forceinline__ void a_ready(const Unit&) const {}
    __device__ __forceinline__ void done(const Unit&) const {}
};

__device__ __forceinline__ unsigned cvt_pk_bf16(float lo, float hi) { unsigned r; asm volatile("v_cvt_pk_bf16_f32 %0, %1, %2" : "=v"(r) : "v"(lo), "v"(hi)); return r; }
typedef float f32x2 __attribute__((ext_vector_type(2)));

typedef unsigned u32x2 __attribute__((ext_vector_type(2)));
__device__ __forceinline__ float bf_lo(unsigned w) { return __uint_as_float(w << 16); }
__device__ __forceinline__ float bf_hi(unsigned w) { return __uint_as_float(w & 0xffff0000u); }
__device__ __forceinline__ float dpp_ror1(float x)  { return __int_as_float(__builtin_amdgcn_update_dpp(0, __float_as_int(x), 0x121, 0xf, 0xf, false)); }
__device__ __forceinline__ float dpp_ror15(float x) { return __int_as_float(__builtin_amdgcn_update_dpp(0, __float_as_int(x), 0x12f, 0xf, 0xf, false)); }
__device__ __forceinline__ float dpp_shr1(float old, float x) { return __int_as_float(__builtin_amdgcn_update_dpp(__float_as_int(old), __float_as_int(x), 0x111, 0xf, 0xf, false)); }
__device__ __forceinline__ float dpp_shl1(float old, float x) { return __int_as_float(__builtin_amdgcn_update_dpp(__float_as_int(old), __float_as_int(x), 0x101, 0xf, 0xf, false)); }


__device__ __forceinline__ float rstd_row(const float* rss, int row, float inv_n) { return rsqrtf(rss[row] * inv_n + 1e-6f); }
struct EpiStoreBf16 {
    static constexpr bool PERM = true, AFTER_DRAIN = false, MIDK = false;
    bf16_t* O; int ldc; const float* rss; float inv_n; int prod_pn;
    __device__ __forceinline__ void operator()(const f32x4 (&acc)[2][2][4][2], const Unit& u, int wr, int wc, int fr, int fq) const {
        const int row0 = u.pm * BM + wr * 64 + fr;
        if (u.pn >= prod_pn) {
            const int col0 = prod_pn * BM + (u.pn - prod_pn) * HALF + wc * 32 + 8 * fq;
#pragma unroll
            for (int ai = 0; ai < 2; ++ai)
#pragma unroll
                for (int m = 0; m < 4; ++m) { const int row = row0 + ai * HALF + m * 16; const float s = rss ? rstd_row(rss, row, inv_n) : 1.f; const float s2 = s * s;
                    const f32x4 v0 = acc[ai][0][m][0] * acc[ai][1][m][0] * s2, v1 = acc[ai][0][m][1] * acc[ai][1][m][1] * s2;
                    u32x4 w; w.x = cvt_pk_bf16(v0[0], v0[1]); w.y = cvt_pk_bf16(v0[2], v0[3]); w.z = cvt_pk_bf16(v1[0], v1[1]); w.w = cvt_pk_bf16(v1[2], v1[3]);
                    *(u32x4*)(O + (size_t)row * ldc + col0) = w; }
            return;
        }
        const int col0 = u.pn * BM + wc * 32 + 8 * fq;
#pragma unroll
        for (int ai = 0; ai < 2; ++ai)
#pragma unroll
            for (int m = 0; m < 4; ++m) { const int row = row0 + ai * HALF + m * 16; bf16_t* rowp = O + (size_t)row * ldc + col0;
                const float s = rss ? rstd_row(rss, row, inv_n) : 1.f;
#pragma unroll
                for (int bj = 0; bj < 2; ++bj) { const f32x4 v0 = acc[ai][bj][m][0] * s, v1 = acc[ai][bj][m][1] * s;
                    u32x4 w; w.x = cvt_pk_bf16(v0[0], v0[1]); w.y = cvt_pk_bf16(v0[2], v0[3]); w.z = cvt_pk_bf16(v1[0], v1[1]); w.w = cvt_pk_bf16(v1[2], v1[3]);
                    *(u32x4*)(rowp + bj * HALF) = w; } }
    }
};
template <bool MIDK_> struct EpiRes {
    static constexpr bool PERM = true, AFTER_DRAIN = false, MIDK = MIDK_; static constexpr int MIDK_T = 8;
    const float* xlo; const float* xhi; const bf16_t* hbase; const bf16_t* pp; bf16_t* hout; float* fout; float* rss; const float* mrss;
    __device__ __forceinline__ void mid(f32x4 (&acc)[2][2][4][2], const Unit& u, int wr, int wc, int fr, int fq) const {
        int z = 0; asm volatile("" : "+v"(z));
        const int rbase = u.pm * BM + wr * 64 + fr + z;
#pragma unroll
        for (int ai = 0; ai < 2; ++ai)
#pragma unroll
            for (int m = 0; m < 4; ++m) { const float s = rstd_row(mrss, rbase + ai * HALF + m * 16, 1.f / 512.f);
#pragma unroll
                for (int bj = 0; bj < 2; ++bj)
#pragma unroll
                    for (int n = 0; n < 2; ++n) acc[ai][bj][m][n] = acc[ai][bj][m][n] * s; }
    }
    __device__ __forceinline__ void operator()(const f32x4 (&acc)[2][2][4][2], const Unit& u, int wr, int wc, int fr, int fq) const {
        const float* xb = (u.pm < 64) ? xlo : xhi;
        const int col0 = u.pn * BM + wc * 32 + 8 * fq;
#pragma unroll
        for (int ai = 0; ai < 2; ++ai) { float ssm[4];
#pragma unroll
            for (int m = 0; m < 4; ++m) { const int row = u.pm * BM + ai * HALF + wr * 64 + m * 16 + fr; const size_t off = (size_t)row * 1024 + col0;
                float ss = 0.f;
#pragma unroll
                for (int bj = 0; bj < 2; ++bj) {
                    float b[8], v[8];
                    if (xlo) { const f32x4 b0 = *(const f32x4*)(xb + off + bj * HALF), b1 = *(const f32x4*)(xb + off + bj * HALF + 4);
                        b[0] = b0[0]; b[1] = b0[1]; b[2] = b0[2]; b[3] = b0[3]; b[4] = b1[0]; b[5] = b1[1]; b[6] = b1[2]; b[7] = b1[3]; }
                    else { const u32x4 w = *(const u32x4*)(hbase + off + bj * HALF);
                        b[0] = bf_lo(w.x); b[1] = bf_hi(w.x); b[2] = bf_lo(w.y); b[3] = bf_hi(w.y); b[4] = bf_lo(w.z); b[5] = bf_hi(w.z); b[6] = bf_lo(w.w); b[7] = bf_hi(w.w); }
#pragma unroll
                    for (int i = 0; i < 4; ++i) { v[i] = acc[ai][bj][m][0][i]; v[4 + i] = acc[ai][bj][m][1][i]; }
                    if (pp) { const u32x4 w = *(const u32x4*)(pp + off + bj * HALF);
                        const float p[8] = {bf_lo(w.x), bf_hi(w.x), bf_lo(w.y), bf_hi(w.y), bf_lo(w.z), bf_hi(w.z), bf_lo(w.w), bf_hi(w.w)};
#pragma unroll
                        for (int i = 0; i < 8; ++i) v[i] = p[i] * __builtin_amdgcn_rcpf(1.f + __builtin_amdgcn_exp2f(-1.4426950408889634f * v[i])); }
#pragma unroll
                    for (int i = 0; i < 8; ++i) v[i] += b[i];
                    if (hout) { u32x4 w; w.x = cvt_pk_bf16(v[0], v[1]); w.y = cvt_pk_bf16(v[2], v[3]); w.z = cvt_pk_bf16(v[4], v[5]); w.w = cvt_pk_bf16(v[6], v[7]);
                        *(u32x4*)(hout + off + bj * HALF) = w;
                        if (rss) { const float r[8] = {bf_lo(w.x), bf_hi(w.x), bf_lo(w.y), bf_hi(w.y), bf_lo(w.z), bf_hi(w.z), bf_lo(w.w), bf_hi(w.w)};
#pragma unroll
                            for (int i = 0; i < 8; ++i) ss += r[i] * r[i]; } }
                    if (fout) { *(f32x4*)(fout + off + bj * HALF) = (f32x4){v[0], v[1], v[2], v[3]}; *(f32x4*)(fout + off + bj * HALF + 4) = (f32x4){v[4], v[5], v[6], v[7]}; }
                }
                if (rss) { ss += __shfl_xor(ss, 16); ss += __shfl_xor(ss, 32); } ssm[m] = ss;
                asm volatile("" ::: "memory"); }
            if (rss) { const float mine = fq == 0 ? ssm[0] : fq == 1 ? ssm[1] : fq == 2 ? ssm[2] : ssm[3];
                __hip_atomic_fetch_add(rss + u.pm * BM + ai * HALF + wr * 64 + 16 * fq + fr, mine, __ATOMIC_RELAXED, __HIP_MEMORY_SCOPE_AGENT); } }
    }
};
struct EpiConvAct {
    static constexpr bool PERM = true, AFTER_DRAIN = false, MIDK = false;
    bf16_t* act; bf16_t* E; const float* cw; PG8_LAS float* H; const float* rss;
    __device__ __forceinline__ void operator()(const f32x4 (&acc)[2][2][4][2], const Unit& u, int wr, int wc, int fr, int fq) const {
        const int ch0 = u.pn * 128 + wc * 32 + 8 * fq;
        float s[2][4];
#pragma unroll
        for (int ai = 0; ai < 2; ++ai)
#pragma unroll
            for (int m = 0; m < 4; ++m) s[ai][m] = rstd_row(rss, u.pm * BM + ai * HALF + wr * 64 + m * 16 + fr, 1.f / 1024.f);
#pragma unroll
        for (int ai = 0; ai < 2; ++ai) { const int seg = 2 * ai + wr;
            if (fr == 0)  { PG8_LAS f32x4* h = (PG8_LAS f32x4*)(H + ((((seg * 2 + 0) * 4 + wc) * 4 + fq) * 16)); const float q = s[ai][0]; h[0] = acc[ai][0][0][0] * q; h[1] = acc[ai][0][0][1] * q; h[2] = acc[ai][1][0][0] * q; h[3] = acc[ai][1][0][1] * q; }
            if (fr == 15) { PG8_LAS f32x4* h = (PG8_LAS f32x4*)(H + ((((seg * 2 + 1) * 4 + wc) * 4 + fq) * 16)); const float q = s[ai][3]; h[0] = acc[ai][0][3][0] * q; h[1] = acc[ai][0][3][1] * q; h[2] = acc[ai][1][3][0] * q; h[3] = acc[ai][1][3][1] * q; } }
        asm volatile("s_waitcnt lgkmcnt(0)" ::: "memory"); __builtin_amdgcn_s_barrier(); asm volatile("" ::: "memory");
#pragma unroll
        for (int n = 0; n < 2; ++n) {
            f32x4 w[2][3];
#pragma unroll
            for (int bj = 0; bj < 2; ++bj)
#pragma unroll
                for (int j = 0; j < 3; ++j) w[bj][j] = *(const f32x4*)(cw + j * 5632 + bj * 2816 + ch0 + 4 * n);
#pragma unroll
            for (int ai = 0; ai < 2; ++ai) { const int seg = 2 * ai + wr;
                f32x4 hp[2], hn[2];
                { const int sp = seg > 0 ? seg - 1 : 0; const PG8_LAS f32x4* h = (const PG8_LAS f32x4*)(H + ((((sp * 2 + 1) * 4 + wc) * 4 + fq) * 16)); hp[0] = h[n]; hp[1] = h[2 + n];
                  if (seg == 0) { hp[0] = (f32x4){0.f, 0.f, 0.f, 0.f}; hp[1] = hp[0]; } }
                { const int sn = seg < 3 ? seg + 1 : 3; const PG8_LAS f32x4* h = (const PG8_LAS f32x4*)(H + ((((sn * 2 + 0) * 4 + wc) * 4 + fq) * 16)); hn[0] = h[n]; hn[1] = h[2 + n];
                  if (seg == 3) { hn[0] = (f32x4){0.f, 0.f, 0.f, 0.f}; hn[1] = hn[0]; } }
                float cv[4][2][4];
#pragma unroll
                for (int bj = 0; bj < 2; ++bj)
#pragma unroll
                    for (int i = 0; i < 4; ++i) {
                        float sv[4];
#pragma unroll
                        for (int m = 0; m < 4; ++m) sv[m] = acc[ai][bj][m][n][i] * s[ai][m];
#pragma unroll
                        for (int m = 0; m < 4; ++m) {
                            const float X = (m > 0) ? dpp_ror1(sv[m > 0 ? m - 1 : 0]) : hp[bj][i];
                            const float Y = (m < 3) ? dpp_ror15(sv[m < 3 ? m + 1 : 3]) : hn[bj][i];
                            const float prv = dpp_shr1(X, sv[m]), nxt = dpp_shl1(Y, sv[m]);
                            cv[m][bj][i] = w[bj][0][i] * prv + w[bj][1][i] * sv[m] + w[bj][2][i] * nxt; }
                    }
#pragma unroll
                for (int m = 0; m < 4; ++m) {
                    float o[4];
#pragma unroll
                    for (int i = 0; i < 4; ++i) o[i] = cv[m][0][i] * __builtin_amdgcn_rcpf(1.f + __builtin_amdgcn_exp2f(-1.4426950408889634f * cv[m][0][i])) * cv[m][1][i];
                    u32x2 pw; pw.x = cvt_pk_bf16(o[0], o[1]); pw.y = cvt_pk_bf16(o[2], o[3]);
                    *(u32x2*)(act + (size_t)(u.pm * BM + ai * HALF + wr * 64 + m * 16 + fr) * 2816 + ch0 + 4 * n) = pw;
                }
            }
            if (wr == 0 && fr < 2) {
#pragma unroll
                for (int bj = 0; bj < 2; ++bj) { const f32x4 v = acc[0][bj][0][n] * s[0][0]; u32x2 pw; pw.x = cvt_pk_bf16(v[0], v[1]); pw.y = cvt_pk_bf16(v[2], v[3]);
                    *(u32x2*)(E + (size_t)(u.pm * 4 + fr) * 5632 + bj * 2816 + ch0 + 4 * n) = pw; } }
            if (wr == 1 && fr >= 14) {
#pragma unroll
                for (int bj = 0; bj < 2; ++bj) { const f32x4 v = acc[1][bj][3][n] * s[1][3]; u32x2 pw; pw.x = cvt_pk_bf16(v[0], v[1]); pw.y = cvt_pk_bf16(v[2], v[3]);
                    *(u32x2*)(E + (size_t)(u.pm * 4 + fr - 12) * 5632 + bj * 2816 + ch0 + 4 * n) = pw; } }
        }
    }
};
template <class Epi, class Sched, bool ALIGN_EPI = false, bool SP2 = false>
__device__ __forceinline__ void gemm_phase(PG8_LAS unsigned char* lds, const Gemm g, const Sched& S, const Epi& E) {
    int tid_ = threadIdx.x; asm volatile("" : "+v"(tid_));
    const int tid = tid_, wid = __builtin_amdgcn_readfirstlane(tid >> 6), lane = tid & 63, wr = wid >> 2, wc = wid & 3, fr = lane & 15, fq = lane >> 4;
    const int K = g.K, nt = K / BK;
    unsigned voffA[2], voffB[2];
#pragma unroll
    for (int i = 0; i < 2; ++i) { int R, C; stage_rc(tid * 16 + i * 8192, R, C); const int Rb = Epi::PERM ? ((R & ~31) + perm32(R & 31)) : R;
        voffA[i] = (unsigned)(R * K + C) * 2u; voffB[i] = (unsigned)(Rb * K + C) * 2u; }
    const size_t kstep = (size_t)(BK * 2);
    const size_t hstep = (size_t)HALF * K * 2;
    const size_t tstep = 2 * hstep;
    const unsigned ldsw = (unsigned)wid * 1024u;
    const int aoff = lds_byte(wr * 64 + fr, fq * 8), boff = lds_byte(wc * 32 + fr, fq * 8);
#define PG8_SA(b, h) (((b) * 2 + (h)) * HTB)
#define PG8_SB(b, h) ((4 + (b) * 2 + (h)) * HTB)
#define PG8_STAGE(bufoff, gbase, voff) do { _Pragma("unroll") for (int _i = 0; _i < 2; ++_i) \
        __builtin_amdgcn_global_load_lds((const unsigned*)((const char*)(gbase) + (voff)[_i]), (PG8_LAS unsigned*)(lds + (bufoff) + ldsw + _i * 8192), 16, 0, 0); } while (0)
#define PG8_LDA(dst, b, h) do { _Pragma("unroll") for (int m = 0; m < 4; ++m) _Pragma("unroll") for (int k = 0; k < 2; ++k) dst[m][k] = *(const PG8_LAS bf16x8*)(lds + PG8_SA(b, h) + aoff + m * 2048 + k * 1024); } while (0)
#define PG8_LDB(dst, b, h) do { _Pragma("unroll") for (int n = 0; n < 2; ++n) _Pragma("unroll") for (int k = 0; k < 2; ++k) dst[n][k] = *(const PG8_LAS bf16x8*)(lds + PG8_SB(b, h) + boff + n * 2048 + k * 1024); } while (0)
#define PG8_MMA(ai, bj, At, Bt) do { __builtin_amdgcn_s_setprio(1); _Pragma("unroll") for (int m = 0; m < 4; ++m) _Pragma("unroll") for (int n = 0; n < 2; ++n) _Pragma("unroll") for (int k = 0; k < 2; ++k) \
        acc[ai][bj][m][n] = __builtin_amdgcn_mfma_f32_16x16x32_bf16(Bt[n][k], At[m][k], acc[ai][bj][m][n], 0, 0, 0); __builtin_amdgcn_s_setprio(0); } while (0)
#define PG8_WAIT_V(n) asm volatile("s_waitcnt vmcnt(" #n ")" ::: "memory")
#define PG8_WAIT_L(n) asm volatile("s_waitcnt lgkmcnt(" #n ")" ::: "memory")
#define PG8_BAR __builtin_amdgcn_s_barrier()
#define PG8_SCHED __builtin_amdgcn_sched_barrier(0)
    Unit cur, nxt; int ui = 0;
    if (!S.next(0, cur)) return;
    f32x4 acc[2][2][4][2];
#pragma unroll
    for (int a = 0; a < 2; ++a)
#pragma unroll
        for (int b = 0; b < 2; ++b)
#pragma unroll
            for (int m = 0; m < 4; ++m)
#pragma unroll
                for (int n = 0; n < 2; ++n) acc[a][b][m][n] = (f32x4){0.f, 0.f, 0.f, 0.f};
    bf16x8 At[4][2], B0[2][2], B1[2][2];
    const char* cA = (const char*)g.A + (size_t)cur.pm * tstep; const char* cB = (const char*)g.Bt + (size_t)cur.pn * tstep;
    S.a_ready(cur);
    if constexpr (SP2) {
        PG8_STAGE(PG8_SB(0, 0), cB, voffB); PG8_STAGE(PG8_SB(0, 1), cB + hstep, voffB); PG8_STAGE(PG8_SA(0, 0), cA, voffA); PG8_STAGE(PG8_SA(0, 1), cA + hstep, voffA);
        if (wr == 1) PG8_BAR;
        PG8_WAIT_V(2); PG8_BAR;
        PG8_STAGE(PG8_SB(1, 0), cB + kstep, voffB); PG8_STAGE(PG8_SA(1, 0), cA + kstep, voffA); PG8_STAGE(PG8_SB(1, 1), cB + hstep + kstep, voffB);
        PG8_WAIT_V(6); PG8_BAR;
    } else {
        PG8_STAGE(PG8_SB(0, 0), cB, voffB); PG8_STAGE(PG8_SA(0, 0), cA, voffA); PG8_STAGE(PG8_SB(0, 1), cB + hstep, voffB); PG8_STAGE(PG8_SA(0, 1), cA + hstep, voffA);
        if (wr == 1) PG8_BAR;
        PG8_WAIT_V(4); PG8_BAR;
        PG8_STAGE(PG8_SB(1, 0), cB + kstep, voffB); PG8_STAGE(PG8_SA(1, 0), cA + kstep, voffA); PG8_STAGE(PG8_SB(1, 1), cB + hstep + kstep, voffB);
        PG8_WAIT_V(6); PG8_BAR;
    }
    for (;;) {
        const bool has_next = S.next(ui + 1, nxt);
        const char* nA = has_next ? (const char*)g.A + (size_t)nxt.pm * tstep : cA; const char* nB = has_next ? (const char*)g.Bt + (size_t)nxt.pn * tstep : cB;
        for (int t = 0; t < nt; t += 2) {
            if constexpr (Epi::MIDK) { if (t == Epi::MIDK_T) E.mid(acc, cur, wr, wc, fr, fq); }
            const bool last = (t == nt - 2);
            const char* a1 = cA + (size_t)(t + 1) * kstep;
            const char* a2 = last ? nA : cA + (size_t)(t + 2) * kstep; const char* b2 = last ? nB : cB + (size_t)(t + 2) * kstep;
            const char* a3 = a2 + kstep; const char* b3 = b2 + kstep;
            if (last && has_next) S.a_ready(nxt);
            if constexpr (SP2) {
            PG8_LDB(B0, 0, 0); PG8_LDB(B1, 0, 1); PG8_SCHED; PG8_LDA(At, 0, 0); PG8_STAGE(PG8_SA(1, 1), a1 + hstep, voffA);
            PG8_WAIT_V(8); PG8_WAIT_L(0); PG8_BAR; PG8_MMA(0, 0, At, B0); PG8_MMA(0, 1, At, B1); PG8_BAR; PG8_SCHED;
            PG8_LDA(At, 0, 1); PG8_STAGE(PG8_SB(0, 0), b2, voffB); PG8_STAGE(PG8_SB(0, 1), b2 + hstep, voffB); PG8_STAGE(PG8_SA(0, 0), a2, voffA);
            PG8_WAIT_V(8); PG8_WAIT_L(0); PG8_BAR; PG8_MMA(1, 0, At, B0); PG8_MMA(1, 1, At, B1); PG8_BAR; PG8_SCHED;
            PG8_LDB(B0, 1, 0); PG8_LDB(B1, 1, 1); PG8_SCHED; PG8_LDA(At, 1, 0); PG8_STAGE(PG8_SA(0, 1), a2 + hstep, voffA);
            PG8_WAIT_V(8); PG8_WAIT_L(0); PG8_BAR; PG8_MMA(0, 0, At, B0); PG8_MMA(0, 1, At, B1); PG8_BAR; PG8_SCHED;
            PG8_LDA(At, 1, 1); PG8_STAGE(PG8_SB(1, 0), b3, voffB); PG8_STAGE(PG8_SB(1, 1), b3 + hstep, voffB); PG8_STAGE(PG8_SA(1, 0), a3, voffA);
            PG8_WAIT_V(8); PG8_WAIT_L(0); PG8_BAR; PG8_MMA(1, 0, At, B0); PG8_MMA(1, 1, At, B1); PG8_BAR; PG8_SCHED;
            } else {
            PG8_LDB(B0, 0, 0); PG8_SCHED; PG8_LDA(At, 0, 0); PG8_STAGE(PG8_SA(1, 1), a1 + hstep, voffA);
            PG8_WAIT_L(8); PG8_BAR; PG8_WAIT_L(0); PG8_MMA(0, 0, At, B0); PG8_BAR; PG8_SCHED;
            PG8_LDB(B1, 0, 1); PG8_STAGE(PG8_SB(0, 0), b2, voffB);
            PG8_BAR; PG8_WAIT_L(0); PG8_MMA(0, 1, At, B1); PG8_BAR;
            PG8_LDA(At, 0, 1); PG8_STAGE(PG8_SA(0, 0), a2, voffA);
            PG8_BAR; PG8_WAIT_L(0); PG8_MMA(1, 0, At, B0); PG8_BAR; PG8_SCHED;
            PG8_STAGE(PG8_SB(0, 1), b2 + hstep, voffB);
            PG8_WAIT_V(6); PG8_BAR; PG8_MMA(1, 1, At, B1); PG8_BAR;
            PG8_LDB(B0, 1, 0); PG8_SCHED; PG8_LDA(At, 1, 0); PG8_STAGE(PG8_SA(0, 1), a2 + hstep, voffA);
            PG8_WAIT_L(8); PG8_BAR; PG8_WAIT_L(0); PG8_MMA(0, 0, At, B0); PG8_BAR; PG8_SCHED;
            PG8_LDB(B1, 1, 1); PG8_STAGE(PG8_SB(1, 0), b3, voffB);
            PG8_BAR; PG8_WAIT_L(0); PG8_MMA(0, 1, At, B1); PG8_BAR;
            PG8_LDA(At, 1, 1); PG8_STAGE(PG8_SA(1, 0), a3, voffA);
            PG8_BAR; PG8_WAIT_L(0); PG8_MMA(1, 0, At, B0); PG8_BAR; PG8_SCHED;
            PG8_STAGE(PG8_SB(1, 1), b3 + hstep, voffB);
            PG8_WAIT_V(6); PG8_BAR; PG8_MMA(1, 1, At, B1); PG8_BAR;
            }
        }
        if constexpr (ALIGN_EPI) { if (wr == 0) PG8_BAR; }
        if constexpr (!Epi::AFTER_DRAIN) { E(acc, cur, wr, wc, fr, fq); S.done(cur); }
        if (!has_next) break;
#pragma unroll
        for (int a = 0; a < 2; ++a)
#pragma unroll
            for (int b = 0; b < 2; ++b)
#pragma unroll
                for (int m = 0; m < 4; ++m)
#pragma unroll
                    for (int n = 0; n < 2; ++n) acc[a][b][m][n] = (f32x4){0.f, 0.f, 0.f, 0.f};
        cur = nxt; cA = nA; cB = nB; ++ui;
        if constexpr (ALIGN_EPI) { if (wr == 1) PG8_BAR; }
    }
    PG8_WAIT_V(0);
    if constexpr (!ALIGN_EPI) { if (wr == 0) PG8_BAR; }
    PG8_BAR;
    if constexpr (Epi::AFTER_DRAIN) { E.fused(acc, cur, wr, wc, fr, fq, lds, wid, lane); S.done(cur); }
#undef PG8_SA
#undef PG8_SB
#undef PG8_STAGE
#undef PG8_LDA
#undef PG8_LDB
#undef PG8_MMA
#undef PG8_WAIT_V
#undef PG8_WAIT_L
#undef PG8_BAR
#undef PG8_SCHED
}
}
#include <hip/hip_bf16.h>
#include <cmath>
namespace attn_body {
using bf16=__hip_bfloat16;
using bf16x8=__attribute__((ext_vector_type(8)))short;
using s16x4=__attribute__((ext_vector_type(4)))short;
using f32x16=__attribute__((ext_vector_type(16)))float;
using u32x4=__attribute__((ext_vector_type(4)))unsigned;
constexpr int D=64,ZP=1792,OP=1024;
constexpr int NW=8,QBLK=32,QB=QBLK*NW,KVBLK=64;
__device__ __forceinline__ int crow(int r,int hi){return (r&3)+8*(r>>2)+4*hi;}
#define SBAR() __builtin_amdgcn_sched_barrier(0)
__device__ __forceinline__ void cmask(f32x16&p0,f32x16&p1,int jb,int qrel,int hi){
  const float NEG=-INFINITY; int kb=64*jb+4*hi;
  #pragma unroll
  for(int r=0;r<16;++r){int kv=kb+(r&3)+8*(r>>2); if(kv>qrel)p0[r]=NEG; if(kv+32>qrel)p1[r]=NEG;}
}

constexpr int NSLOT=3, SLOTB=8192;
constexpr int LDS_K=0, LDS_V=NSLOT*SLOTB, LDS_WS=2*NSLOT*SLOTB, LDS_OST=LDS_WS+NW*64*4, LDS_BYTES=LDS_OST+NW*4096;
constexpr float C2=0.125f*1.4426950408889634f;
__device__ __forceinline__ void glds16(const void*gsrc,unsigned lds_dst){unsigned keep;
  asm volatile("s_mov_b32 %0, m0\n\ts_mov_b32 m0, %2\n\ts_nop 0\n\tglobal_load_lds_dwordx4 %1, off\n\ts_mov_b32 m0, %0":"=&s"(keep):"v"(gsrc),"s"(lds_dst):"memory");}
__device__ __forceinline__ float max3f(float a,float b,float c){float r;asm("v_max3_f32 %0, %1, %2, %3":"=v"(r):"v"(a),"v"(b),"v"(c));return r;}
__device__ __forceinline__ float max2f(float a,float b){float r;asm("v_max_f32_e32 %0, %1, %2":"=v"(r):"v"(a),"v"(b));return r;}
__device__ __forceinline__ float fadd_s(float a,float b){float r;asm("v_add_f32_e32 %0, %1, %2":"=v"(r):"v"(a),"v"(b));return r;}
__device__ __forceinline__ float fsub_s(float a,float b){float r;asm("v_sub_f32_e32 %0, %1, %2":"=v"(r):"v"(a),"v"(b));return r;}
typedef float f32x2_t __attribute__((ext_vector_type(2))); typedef __bf16 bf16x2_t __attribute__((ext_vector_type(2)));
__device__ __forceinline__ unsigned cvtpk_s(float lo,float hi){f32x2_t v={lo,hi};bf16x2_t b=__builtin_convertvector(v,bf16x2_t);return __builtin_bit_cast(unsigned,b);}
#define WAIT_BAR(N) asm volatile("s_waitcnt vmcnt(" #N ") lgkmcnt(0)\n\ts_barrier":::"memory")

__device__ __forceinline__ void qkt(f32x16&p0,f32x16&p1,const char*Kslot,const bf16x8*qr,const f32x16&negm,int r32,int hi){
  const char*kb=Kslot+hi*1024+r32*16;
  #pragma unroll
  for(int d0=0;d0<4;++d0){
    const bf16x8 b0=*reinterpret_cast<const bf16x8*>(kb+d0*2048);
    const bf16x8 b1=*reinterpret_cast<const bf16x8*>(kb+d0*2048+512);
    if(d0==0){p0=__builtin_amdgcn_mfma_f32_32x32x16_bf16(b0,qr[0],negm,0,0,0);p1=__builtin_amdgcn_mfma_f32_32x32x16_bf16(b1,qr[0],negm,0,0,0);}
    else{p0=__builtin_amdgcn_mfma_f32_32x32x16_bf16(b0,qr[d0],p0,0,0,0);p1=__builtin_amdgcn_mfma_f32_32x32x16_bf16(b1,qr[d0],p1,0,0,0);}}
}
typedef __attribute__((address_space(3))) const char* lds_cptr;
typedef short v4i16_t __attribute__((ext_vector_type(4)));
__device__ __forceinline__ void kload8(bf16x8*kf,lds_cptr kp){
  kf[0]=*(const __attribute__((address_space(3))) bf16x8*)(kp);      kf[1]=*(const __attribute__((address_space(3))) bf16x8*)(kp+512);
  kf[2]=*(const __attribute__((address_space(3))) bf16x8*)(kp+2048); kf[3]=*(const __attribute__((address_space(3))) bf16x8*)(kp+2560);
  kf[4]=*(const __attribute__((address_space(3))) bf16x8*)(kp+4096); kf[5]=*(const __attribute__((address_space(3))) bf16x8*)(kp+4608);
  kf[6]=*(const __attribute__((address_space(3))) bf16x8*)(kp+6144); kf[7]=*(const __attribute__((address_space(3))) bf16x8*)(kp+6656);
}
__device__ __forceinline__ void kload2(bf16x8*kf,lds_cptr kp,int j){ kf[2*j]=*(const __attribute__((address_space(3))) bf16x8*)(kp+j*2048); kf[2*j+1]=*(const __attribute__((address_space(3))) bf16x8*)(kp+j*2048+512); }
__device__ __forceinline__ s16x4 vtr(lds_cptr p){ return __builtin_bit_cast(s16x4,__builtin_amdgcn_ds_read_tr16_b64_v4i16((__attribute__((address_space(3))) v4i16_t*)p)); }
__device__ __forceinline__ float rowmax(const f32x16&p0,const f32x16&p1){
  float a=max3f(p0[0],p0[1],p1[0]),b=max3f(p0[2],p0[3],p1[1]);a=max3f(a,p1[2],p1[3]);
  #pragma unroll
  for(int r=4;r<16;r+=4){a=max3f(a,p0[r],p0[r+1]);b=max3f(b,p0[r+2],p0[r+3]);a=max3f(a,p1[r],p1[r+1]);b=max3f(b,p1[r+2],p1[r+3]);}
  const float m=max2f(a,b);
  auto rr=__builtin_amdgcn_permlane32_swap(__float_as_uint(m),__float_as_uint(m),false,false);
  return max2f(__uint_as_float(rr[0]),__uint_as_float(rr[1]));
}
__device__ __forceinline__ void pv(f32x16*o,int vb,bf16x8 pa0,bf16x8 pa1,bf16x8 pa2,bf16x8 pa3){
  #pragma unroll
  for(int d0=0;d0<2;++d0){s16x4 lo[4],hi[4];
    #pragma unroll
    for(int ks=0;ks<4;++ks){
      asm volatile("ds_read_b64_tr_b16 %0,%1 offset:%c2":"=&v"(lo[ks]):"v"(vb),"i"(d0*4096+ks*1024):"memory");
      asm volatile("ds_read_b64_tr_b16 %0,%1 offset:%c2":"=&v"(hi[ks]):"v"(vb),"i"(d0*4096+ks*1024+512):"memory");}
    asm volatile("s_waitcnt lgkmcnt(0)":::"memory");SBAR();
    #define PK(k) (bf16x8){lo[k][0],lo[k][1],lo[k][2],lo[k][3],hi[k][0],hi[k][1],hi[k][2],hi[k][3]}
    o[d0]=__builtin_amdgcn_mfma_f32_32x32x16_bf16(pa0,PK(0),o[d0],0,0,0);
    o[d0]=__builtin_amdgcn_mfma_f32_32x32x16_bf16(pa1,PK(1),o[d0],0,0,0);
    o[d0]=__builtin_amdgcn_mfma_f32_32x32x16_bf16(pa2,PK(2),o[d0],0,0,0);
    o[d0]=__builtin_amdgcn_mfma_f32_32x32x16_bf16(pa3,PK(3),o[d0],0,0,0);
    #undef PK
  }
}

#ifndef ATTN_STORE16
#define ATTN_STORE16(p,v) (*(u32x4*)(p)=(v))
#endif
template<int THRL> __device__ __forceinline__ void attn_unit(long rowbase,int S,int h,int qb,const bf16*__restrict__ Z,bf16*O,float*rss,const float*__restrict__ qg,const float*__restrict__ rope,char*shm){
  int tid_=threadIdx.x; asm volatile("":"+v"(tid_)); const int tid=tid_,lane=tid&63,r32=lane&31,hi=lane>>5; const int wid=__builtin_amdgcn_readfirstlane(tid>>6);
  const int q0=qb*QB;
  const bf16*Qw=Z+(rowbase+q0+wid*QBLK)*ZP+h*D;
  const bf16*Kh=Z+rowbase*ZP+512+(h>>2)*D,*Vh=Z+rowbase*ZP+640+(h>>2)*D;
  const unsigned lds0=(unsigned)(uintptr_t)shm;
  float*wsf=(float*)(shm+LDS_WS)+wid*64;
  const bf16*ksrc=Kh+(long)lane*ZP+wid*8;
  const bf16*vsrc=Vh+(long)(16*(wid&3)+(lane>>2))*ZP+(wid>>2)*32+(lane&3)*8;
  const unsigned kdst=lds0+LDS_K+wid*1024, vdst=lds0+LDS_V+wid*1024;
  #define DMA_K(t,slot) glds16(ksrc+(long)(t)*KVBLK*ZP,(unsigned)__builtin_amdgcn_readfirstlane(kdst+(slot)))
  #define DMA_V(t,slot) glds16(vsrc+(long)(t)*KVBLK*ZP,(unsigned)__builtin_amdgcn_readfirstlane(vdst+(slot)))
  const int vb0=(int)(lds0+LDS_V)+((lane>>4)&1)*32+(lane&3)*8+(4*hi+((lane&15)>>2))*64;
  const char*Kbase=shm+LDS_K; bf16x8 kf[8];
  const lds_cptr shm3=(lds_cptr)shm; const lds_cptr kp0=shm3+LDS_K+hi*1024+r32*16; const lds_cptr vp0=shm3+LDS_V+((lane>>4)&1)*32+(lane&3)*8+(4*hi+((lane&15)>>2))*64;
  const int NT=S/KVBLK;
  DMA_K(0,0);DMA_V(0,0);DMA_K(1,SLOTB);
  bf16x8 qr[4];
  #pragma unroll
  for(int d0=0;d0<4;++d0)qr[d0]=*reinterpret_cast<const bf16x8*>(&Qw[(long)r32*ZP+d0*16+hi*8]);
  float mhat=0.f,l_reg=0.f;f32x16 o[2];o[0]=f32x16{};o[1]=f32x16{};f32x16 negm=f32x16{};asm volatile("":"+v"(negm));
  const int qrel=wid*QBLK+r32;
  #define CMASK(P0,P1,t) do{}while(0)
  bool resc=false;
  #define START(P0,P1) do{ const float rm=rowmax(P0,P1); resc=false; \
    { const float dl=rm; mhat=fadd_s(mhat,dl); \
      _Pragma("unroll") for(int r=0;r<16;++r){P0[r]=fsub_s(P0[r],dl);P1[r]=fsub_s(P1[r],dl);} \
      _Pragma("unroll") for(int r=0;r<16;++r)negm[r]=-mhat; asm volatile("":"+v"(negm)); } \
    _Pragma("unroll") for(int r=0;r<16;++r)P0[r]=__builtin_amdgcn_exp2f(P0[r]); }while(0)
  #define RESC() do{ if(resc){ asm volatile("s_waitcnt lgkmcnt(0)":::"memory"); \
      _Pragma("unroll") for(int d_=0;d_<2;++d_) _Pragma("unroll") for(int r=0;r<16;++r)o[d_][r]*=wsf[crow(r,hi)]; } }while(0)
  f32x16 pA0,pA1,pB0,pB1;
  int sl_prev=0,sl_cur=0,sl_next=SLOTB;
  #define ROT() do{sl_prev=sl_cur;sl_cur=sl_next;sl_next=(sl_next==(NSLOT-1)*SLOTB)?0:sl_next+SLOTB;}while(0)
  DMA_K(2,2*SLOTB);
  {
    const int tq=q0+wid*QBLK+r32; float x[4][8]; float ss=0.f;
    #pragma unroll
    for(int d0=0;d0<4;++d0){
      #pragma unroll
      for(int j=0;j<8;++j){x[d0][j]=__uint_as_float((unsigned)(unsigned short)qr[d0][j]<<16); ss+=x[d0][j]*x[d0][j];}}
    {auto rr=__builtin_amdgcn_permlane32_swap(__float_as_uint(ss),__float_as_uint(ss),false,false); ss=__uint_as_float(rr[0])+__uint_as_float(rr[1]);}
    const float rstd=__builtin_amdgcn_rsqf(ss*(1.f/64.f)+1e-6f);
    #pragma unroll
    for(int d0=0;d0<4;++d0){
      #pragma unroll
      for(int j=0;j<8;++j)x[d0][j]*=rstd*qg[16*d0+8*hi+j];}
    const float*tr=rope+(size_t)((tq>>6)*16+8*hi)*2,*tc=rope+(size_t)((tq&63)*16+8*hi)*2;
    #pragma unroll
    for(int j=0;j<8;++j){
      const float cr=tr[2*j],sr=tr[2*j+1],cc=tc[2*j],sc=tc[2*j+1];
      const float a=x[0][j],b=x[1][j],e=x[2][j],f=x[3][j];
      x[0][j]=(a*cr-b*sr)*C2; x[1][j]=(b*cr+a*sr)*C2; x[2][j]=(e*cc-f*sc)*C2; x[3][j]=(f*cc+e*sc)*C2;}
    #pragma unroll
    for(int d0=0;d0<4;++d0){u32x4 w; w[0]=cvtpk_s(x[d0][0],x[d0][1]);w[1]=cvtpk_s(x[d0][2],x[d0][3]);w[2]=cvtpk_s(x[d0][4],x[d0][5]);w[3]=cvtpk_s(x[d0][6],x[d0][7]); qr[d0]=__builtin_bit_cast(bf16x8,w);}
  }
  WAIT_BAR(3);
  qkt(pA0,pA1,Kbase,qr,negm,r32,hi);asm volatile("s_nop 15\n\ts_nop 7":"+v"(pA0),"+v"(pA1));CMASK(pA0,pA1,0);
  START(pA0,pA1);
  _Pragma("unroll") for(int r=0;r<16;++r)pA1[r]=__builtin_amdgcn_exp2f(pA1[r]);
  WAIT_BAR(0);
  DMA_K(3,0);DMA_V(1,SLOTB);
  ROT();
  kload8(kf,kp0+sl_cur);
  WAIT_BAR(2);
  s16x4 vlo[8],vhi[8]; u32x4 pw0,pw1,pw2,pw3;
  #define PKW(P,B) cvtpk_s(P[B],P[B+1])
  #define PAF(k) __builtin_bit_cast(bf16x8,pw##k)
  #define VFR(i) (bf16x8){vlo[i][0],vlo[i][1],vlo[i][2],vlo[i][3],vhi[i][0],vhi[i][1],vhi[i][2],vhi[i][3]}
  #define PIN(x) asm volatile("":"+v"(x))
  #define MX3(a,b,c) __builtin_fmaxf(__builtin_fmaxf((a),(b)),(c))
  #define GAPA(MF,A0,A1,A2,A3,W0,W1,PW) do{ MF; sacc+=A0; sacc+=A1; sacc+=A2; sacc+=A3; PIN(sacc); W0; W1; PIN(PW); SBAR(); }while(0)
  #define EX(v) __builtin_amdgcn_exp2f(v)
  #define GAPB(MF,X,B) do{ MF; X[B]=EX(X[B]); X[B+1]=EX(X[B+1]); X[B+2]=EX(X[B+2]); X[B+3]=EX(X[B+3]); PIN(X); SBAR(); }while(0)
  #define VRD(i) do{ vlo[i]=vtr(vp_+(((i)>>2)*4096+((i)&3)*1024)); vhi[i]=vtr(vp_+(((i)>>2)*4096+((i)&3)*1024+512)); }while(0)
  #define KRD(G,j) do{ if(G){ kload2(kf,kp0+sl_next,j); SBAR(); } }while(0)
  #define STEP(C0,C1,P0,P1,t,GK,GV,GL) do{ SBAR(); \
    const lds_cptr vp_=vp0+sl_prev; \
    VRD(0); SBAR(); float sacc=(P0[0]+P0[1]); \
    GAPA(C0=__builtin_amdgcn_mfma_f32_32x32x16_bf16(kf[0],qr[0],negm,0,0,0), P0[2],P0[3],P0[4],P0[5],     pw0[0]=PKW(P0,0), pw0[1]=PKW(P0,2), pw0); \
    VRD(4); SBAR(); GAPA(C1=__builtin_amdgcn_mfma_f32_32x32x16_bf16(kf[1],qr[0],negm,0,0,0), P0[6],P0[7],P0[8],P0[9],     pw0[2]=PKW(P0,4), pw0[3]=PKW(P0,6), pw0); \
    VRD(1); SBAR(); GAPA(C0=__builtin_amdgcn_mfma_f32_32x32x16_bf16(kf[2],qr[1],C0,0,0,0),   P0[10],P0[11],P0[12],P0[13], pw1[0]=PKW(P0,8), pw1[1]=PKW(P0,10), pw1); \
    VRD(5); SBAR(); GAPA(C1=__builtin_amdgcn_mfma_f32_32x32x16_bf16(kf[3],qr[1],C1,0,0,0),   P0[14],P0[15],P1[0],P1[1],   pw1[2]=PKW(P0,12),pw1[3]=PKW(P0,14), pw1); \
    VRD(2); SBAR(); GAPA(C0=__builtin_amdgcn_mfma_f32_32x32x16_bf16(kf[4],qr[2],C0,0,0,0),   P1[2],P1[3],P1[4],P1[5],     pw2[0]=PKW(P1,0), pw2[1]=PKW(P1,2), pw2); \
    VRD(6); SBAR(); GAPA(C1=__builtin_amdgcn_mfma_f32_32x32x16_bf16(kf[5],qr[2],C1,0,0,0),   P1[6],P1[7],P1[8],P1[9],     pw2[2]=PKW(P1,4), pw2[3]=PKW(P1,6), pw2); \
    VRD(3); SBAR(); GAPA(C0=__builtin_amdgcn_mfma_f32_32x32x16_bf16(kf[6],qr[3],C0,0,0,0),   P1[10],P1[11],P1[12],P1[13], pw3[0]=PKW(P1,8), pw3[1]=PKW(P1,10), pw3); \
    VRD(7); SBAR(); GAPA(C1=__builtin_amdgcn_mfma_f32_32x32x16_bf16(kf[7],qr[3],C1,0,0,0),   P1[14],P1[15],0.f,0.f,       pw3[2]=PKW(P1,12),pw3[3]=PKW(P1,14), pw3); \
    l_reg+=sacc; \
    if(GK){DMA_K((t)+3,sl_cur);} if(GV){DMA_V((t)+1,sl_next);} \
    CMASK(C0,C1,t); \
    { float a=MX3(C0[0],C0[1],C1[0]),b=MX3(C0[2],C0[3],C1[1]); a=MX3(a,C1[2],C1[3]); \
      _Pragma("unroll") for(int r=4;r<16;r+=4){a=MX3(a,C0[r],C0[r+1]);b=MX3(b,C0[r+2],C0[r+3]);a=MX3(a,C1[r],C1[r+1]);b=MX3(b,C1[r+2],C1[r+3]);} \
      float rm=__builtin_fmaxf(a,b); { auto rr=__builtin_amdgcn_permlane32_swap(__float_as_uint(rm),__float_as_uint(rm),false,false); rm=__builtin_fmaxf(__uint_as_float(rr[0]),__uint_as_float(rr[1])); } \
      resc=false; \
      if(__builtin_expect(__any(rm>(float)THRL),0)){ const float dl=__builtin_fmaxf(rm,0.f); mhat+=dl; \
        _Pragma("unroll") for(int r=0;r<16;++r){C0[r]-=dl;C1[r]-=dl;} \
        _Pragma("unroll") for(int r=0;r<16;++r)negm[r]=-mhat; asm volatile("":"+v"(negm)); \
        const float f=__builtin_amdgcn_exp2f(-dl); l_reg*=f; if(hi==0)wsf[r32]=f; resc=true; } } \
    SBAR(); \
    GAPB(o[0]=__builtin_amdgcn_mfma_f32_32x32x16_bf16(PAF(0),VFR(0),o[0],0,0,0), C0,0); \
    GAPB(o[1]=__builtin_amdgcn_mfma_f32_32x32x16_bf16(PAF(0),VFR(4),o[1],0,0,0), C0,4); \
    KRD(GL,0); GAPB(o[0]=__builtin_amdgcn_mfma_f32_32x32x16_bf16(PAF(1),VFR(1),o[0],0,0,0), C0,8); \
    KRD(GL,1); GAPB(o[1]=__builtin_amdgcn_mfma_f32_32x32x16_bf16(PAF(1),VFR(5),o[1],0,0,0), C0,12); \
    KRD(GL,2); GAPB(o[0]=__builtin_amdgcn_mfma_f32_32x32x16_bf16(PAF(2),VFR(2),o[0],0,0,0), C1,0); \
    KRD(GL,3); GAPB(o[1]=__builtin_amdgcn_mfma_f32_32x32x16_bf16(PAF(2),VFR(6),o[1],0,0,0), C1,4); \
    GAPB(o[0]=__builtin_amdgcn_mfma_f32_32x32x16_bf16(PAF(3),VFR(3),o[0],0,0,0), C1,8); \
    GAPB(o[1]=__builtin_amdgcn_mfma_f32_32x32x16_bf16(PAF(3),VFR(7),o[1],0,0,0), C1,12); \
    }while(0)
  int t=1;
  #undef CMASK
  #define CMASK(P0,P1,t) do{}while(0)
  for(;t+5<NT;t+=2){
    STEP(pB0,pB1,pA0,pA1,t,true,true,true);     WAIT_BAR(2); RESC(); ROT();
    STEP(pA0,pA1,pB0,pB1,t+1,true,true,true);   WAIT_BAR(2); RESC(); ROT();
  }
  #undef CMASK
  #define CMASK(P0,P1,t) do{}while(0)
  #define ENDW(tt) do{ if((tt)+3<NT){WAIT_BAR(2);} else if((tt)+2<NT){WAIT_BAR(1);} else {WAIT_BAR(0);} }while(0)
  for(;t+1<NT;t+=2){
    STEP(pB0,pB1,pA0,pA1,t,(t+3<NT),(t+1<NT),(t+1<NT));       ENDW(t);   RESC(); ROT();
    STEP(pA0,pA1,pB0,pB1,t+1,(t+4<NT),(t+2<NT),(t+2<NT));     ENDW(t+1); RESC(); ROT();
  }
  STEP(pB0,pB1,pA0,pA1,NT-1,false,false,false); RESC();
  { float sacc=pB0[0]+pB0[1]; _Pragma("unroll") for(int r=2;r<16;++r)sacc+=pB0[r]; _Pragma("unroll") for(int r=0;r<16;++r)sacc+=pB1[r]; l_reg+=sacc;
    pw0=(u32x4){PKW(pB0,0),PKW(pB0,2),PKW(pB0,4),PKW(pB0,6)};pw1=(u32x4){PKW(pB0,8),PKW(pB0,10),PKW(pB0,12),PKW(pB0,14)};pw2=(u32x4){PKW(pB1,0),PKW(pB1,2),PKW(pB1,4),PKW(pB1,6)};pw3=(u32x4){PKW(pB1,8),PKW(pB1,10),PKW(pB1,12),PKW(pB1,14)};
    SBAR(); pv(o,vb0+sl_cur,PAF(0),PAF(1),PAF(2),PAF(3)); }
  #undef PKW
  #undef PAF
  #undef VFR
  #undef PIN
  #undef MX3
  #undef GAPA
  #undef GAPB
  #undef EX
  #undef VRD
  #undef KRD
  #undef STEP
  #undef ENDW
  {auto rr=__builtin_amdgcn_permlane32_swap(__float_as_uint(l_reg),__float_as_uint(l_reg),false,false);l_reg=__uint_as_float(rr[0])+__uint_as_float(rr[1]);}
  if(hi==0)wsf[32+r32]=l_reg;asm volatile("s_waitcnt lgkmcnt(0)":::"memory");
  float rli[16];
  #pragma unroll
  for(int r=0;r<16;++r)rli[r]=__builtin_amdgcn_rcpf(wsf[32+crow(r,hi)]);
  bf16*Ow=O+(rowbase+q0+wid*QBLK)*OP+h*D;
  { bf16*stg=(bf16*)(shm+LDS_OST)+wid*2048;
    #pragma unroll
    for(int r=0;r<16;++r){const int orow=crow(r,hi);
      #pragma unroll
      for(int d0=0;d0<2;++d0)stg[orow*64+d0*32+r32]=__float2bfloat16(o[d0][r]*rli[r]);}
    asm volatile("s_waitcnt lgkmcnt(0)":::"memory");
    float rs4[4];
    #pragma unroll
    for(int i=0;i<4;++i){const int row=i*8+(lane>>3),ch=lane&7; const u32x4 v=*(const u32x4*)(stg+row*64+ch*8); ATTN_STORE16(Ow+(long)row*OP+ch*8,v);
      float s=0.f;
      #pragma unroll
      for(int j=0;j<4;++j){const float lo=__uint_as_float(v[j]<<16),hh=__uint_as_float(v[j]&0xffff0000u); s+=lo*lo+hh*hh;}
      s+=__shfl_xor(s,1);s+=__shfl_xor(s,2);s+=__shfl_xor(s,4); rs4[i]=s;}
    { const int ch=lane&7;
      const float mine=ch==0?rs4[0]:ch==1?rs4[1]:ch==2?rs4[2]:rs4[3];
      if(ch<4)__hip_atomic_fetch_add(rss+rowbase+q0+wid*QBLK+ch*8+(lane>>3),mine,__ATOMIC_RELAXED,__HIP_MEMORY_SCOPE_AGENT);} }
  asm volatile("s_waitcnt lgkmcnt(0)\n\ts_barrier":::"memory");
  #undef DMA_K
  #undef DMA_V
  #undef CMASK
  #undef START
  #undef RESC
  #undef ROT
}
constexpr int ATTN_LDS_BYTES=LDS_BYTES;
#undef SBAR
#undef WAIT_BAR
}
#define LAS __attribute__((address_space(3)))
#define XB_TMO      128
#define XB_XCNT(j)  (256  + 64 * (j))
#define XB_XSUB(j)  (1280 + 64 * (j))
#define XB_XGEN(j)  (2304 + 64 * (j))
#define XB_TOP      3328
#define XB_TOPGEN   3392
#define XCD_BAR_WORDS 3456
#define XB_SPIN_CAP (1u << 18)

__device__ __forceinline__ unsigned xb_ld(unsigned* p)              { return __hip_atomic_load(p, __ATOMIC_RELAXED, __HIP_MEMORY_SCOPE_AGENT); }
__device__ __forceinline__ unsigned xb_add(unsigned* p, unsigned v) { return __hip_atomic_fetch_add(p, v, __ATOMIC_RELAXED, __HIP_MEMORY_SCOPE_AGENT); }
__device__ __forceinline__ unsigned xb_xcc_id() { return (unsigned)__builtin_amdgcn_s_getreg((3 << 11) | 20) & 0xFu; }
#define XB_SPIN(cond, bar) do { unsigned _sp = 0; while (cond) { __builtin_amdgcn_s_sleep(1); \
    if ((++_sp & 255u) == 0u) { if (xb_ld(&(bar)[XB_TMO])) break; if (_sp > XB_SPIN_CAP) { atomicAdd(&(bar)[XB_TMO], 1u); break; } } } } while (0)

struct XcdBarrier {
    unsigned* bar; unsigned x;
    volatile LAS unsigned* st;
};

__device__ __forceinline__ XcdBarrier xcd_barrier_post(unsigned* bar, volatile LAS unsigned* st) {
    XcdBarrier b; b.bar = bar; b.x = xb_xcc_id(); b.st = st;
    if (threadIdx.x == 0) (void)xb_add(&bar[XB_XCNT(b.x)], 1u);
    return b;
}
__device__ __forceinline__ void xcd_barrier_complete(unsigned* bar, unsigned x, unsigned& nloc, unsigned& nx) {
    const unsigned G = gridDim.x * gridDim.y * gridDim.z;
    unsigned sum, cnt, mine, sp = 0u;
    for (;;) {
        sum = 0u; cnt = 0u; mine = 0u;
#pragma unroll
        for (unsigned j = 0; j < 16; ++j) { const unsigned c = xb_ld(&bar[XB_XCNT(j)]); sum += c; cnt += (c > 0u) ? 1u : 0u; mine = (j == x) ? c : mine; }
        if (sum == G) break;
        __builtin_amdgcn_s_sleep(1);
        if ((++sp & 255u) == 0u) { if (xb_ld(&bar[XB_TMO])) break; if (sp > XB_SPIN_CAP) { atomicAdd(&bar[XB_TMO], 1u); break; } }
    }
    nloc = mine > 0u ? mine : 1u; nx = cnt > 0u ? cnt : 1u;
}

__device__ __forceinline__ void xcd_barrier(const XcdBarrier& b) {
    asm volatile("s_waitcnt vmcnt(0)" ::: "memory");
    __syncthreads();
    if (threadIdx.x == 0) {
        unsigned* bar = b.bar;
        __builtin_amdgcn_s_waitcnt(0);
        unsigned nloc = b.st[0], nx = b.st[1];
        if (nloc == 0u) { xcd_barrier_complete(bar, b.x, nloc, nx); b.st[0] = nloc; b.st[1] = nx; }
        const unsigned old = xb_add(&bar[XB_XSUB(b.x)], 1u);
        const unsigned gen = old / nloc;
        if (old + 1u == (gen + 1u) * nloc) {
            __builtin_amdgcn_fence(__ATOMIC_RELEASE, "agent");
            asm volatile("s_waitcnt vmcnt(0)" ::: "memory");
            const unsigned og = xb_add(&bar[XB_TOP], 1u);
            const unsigned tg = og / nx;
            if (og + 1u == (tg + 1u) * nx) xb_add(&bar[XB_TOPGEN], 1u);
            else XB_SPIN(xb_ld(&bar[XB_TOPGEN]) == tg, bar);
            __builtin_amdgcn_fence(__ATOMIC_ACQUIRE, "agent");
            xb_add(&bar[XB_XGEN(b.x)], 1u);
            asm volatile("s_waitcnt vmcnt(0)" ::: "memory");
        } else {
            XB_SPIN(xb_ld(&bar[XB_XGEN(b.x)]) == gen, bar);
            __builtin_amdgcn_fence(__ATOMIC_ACQUIRE, "agent");
            asm volatile("s_waitcnt vmcnt(0)" ::: "memory");
        }
    }
    __syncthreads();
}

constexpr int NWAVES = 8;
constexpr int M = 32768, MP = 16384, DMODEL = 1024, DIN = 2304, ZW = 1792  , DFF = 2816, NUP = 5632, PLE = 256, SP = 4096, SS = 2048;
constexpr float EPS = 1e-6f;
constexpr size_t MiB = 1u << 20;
constexpr size_t WS_ROPE = 0;
constexpr size_t WS_WIN = 1 * MiB;
constexpr size_t WS_WOUT = WS_WIN + (size_t)DIN * DMODEL * 2;
constexpr size_t WS_WUP = WS_WOUT + (size_t)DMODEL * DMODEL * 2;
constexpr size_t WS_WDOWN = WS_WUP + (size_t)NUP * DMODEL * 2;
constexpr size_t WS_WGATE = WS_WDOWN + (size_t)DMODEL * DFF * 2;
constexpr size_t WS_WPROJ = WS_WGATE + (size_t)DMODEL * DMODEL * 2;
constexpr size_t WS_RSS = 27 * MiB;
constexpr size_t WS_A = 28 * MiB;
constexpr size_t WS_BIG = 92 * MiB;
constexpr size_t WS_W2 = 268 * MiB;
constexpr size_t HB_E = 32 * MiB;
constexpr size_t WS_P16 = 274 * MiB;
constexpr size_t WS_END = 290 * MiB;
static_assert(WS_WPROJ + (size_t)DMODEL * PLE * 2 <= WS_A, "weights fit");
constexpr int RING_BYTES = 131072, MISC_OFF = RING_BYTES, HALO_OFF = RING_BYTES + 1024, LDS_BYTES = 147456;
constexpr size_t WS_CTL = 512 * 1024, CTL_BYTES = 64 * 1024;

typedef unsigned short bf16;
typedef unsigned v4u __attribute__((ext_vector_type(4)));
typedef unsigned v2u __attribute__((ext_vector_type(2)));
typedef float f32x4 __attribute__((ext_vector_type(4)));

__device__ __forceinline__ unsigned pk2(float lo, float hi) { return pg8::cvt_pk_bf16(lo, hi); }
__device__ __forceinline__ float bflo(unsigned w) { return __uint_as_float(w << 16); }
__device__ __forceinline__ float bfhi(unsigned w) { return __uint_as_float(w & 0xffff0000u); }
__device__ __forceinline__ void unpack8(const v4u v, float* f) { f[0] = bflo(v.x); f[1] = bfhi(v.x); f[2] = bflo(v.y); f[3] = bfhi(v.y); f[4] = bflo(v.z); f[5] = bfhi(v.z); f[6] = bflo(v.w); f[7] = bfhi(v.w); }
__device__ __forceinline__ v4u pack8(const float* f) { v4u o; o.x = pk2(f[0], f[1]); o.y = pk2(f[2], f[3]); o.z = pk2(f[4], f[5]); o.w = pk2(f[6], f[7]); return o; }
#define DPPF(x, ctrl) __int_as_float(__builtin_amdgcn_update_dpp(0, __float_as_int(x), (ctrl), 0xf, 0xf, false))
__device__ __forceinline__ float sum8(float v) {
    v += DPPF(v, 0xB1); v += DPPF(v, 0x4E); v += DPPF(v, 0x141); return v;
}
__device__ __forceinline__ float wave_sum(float v) {
    v = sum8(v); v += DPPF(v, 0x128);
    return __int_as_float(__builtin_amdgcn_readlane(__float_as_int(v), 0)) + __int_as_float(__builtin_amdgcn_readlane(__float_as_int(v), 16))
         + __int_as_float(__builtin_amdgcn_readlane(__float_as_int(v), 32)) + __int_as_float(__builtin_amdgcn_readlane(__float_as_int(v), 48));
}
struct Args { void* p[20]; };

struct TItem { const float* W; bf16* WT; const float* ks; int K, N, mode, kmax, item; };
__device__ __forceinline__ void titem_load(const TItem& t, f32x4 (&v)[8], int lane) {
    const int nblk = t.N / 32, kb = t.item / nblk, nb = t.item % nblk, k0 = 64 * kb, n0 = 32 * nb;
#pragma unroll
    for (int i = 0; i < 8; ++i) { const int kk = 8 * i + (lane >> 3), nq = (lane & 7) * 4; v[i] = __builtin_nontemporal_load((const f32x4*)(t.W + (size_t)(k0 + kk) * t.N + n0 + nq)); }
}
__device__ __forceinline__ void titem_finish(const TItem& t, f32x4 (&v)[8], float* scr, int lane) {
    const int nblk = t.N / 32, kb = t.item / nblk, nb = t.item % nblk, k0 = 64 * kb, n0 = 32 * nb;
#pragma unroll
    for (int i = 0; i < 8; ++i) { const int kk = 8 * i + (lane >> 3), nq = (lane & 7) * 4; f32x4 x = v[i];
        if (t.ks && k0 + kk < t.kmax) x = x * t.ks[k0 + kk];
        float* d = scr + kk * 33 + nq; d[0] = x.x; d[1] = x.y; d[2] = x.z; d[3] = x.w; }
    __builtin_amdgcn_s_waitcnt(0xc07f); asm volatile("" ::: "memory");
    int r0 = n0;
    if (t.mode == 1) { r0 = (n0 < DFF) ? 256 * (n0 / 128) + n0 % 128 : 256 * ((n0 - DFF) / 128) + 128 + (n0 - DFF) % 128; }
    if (t.mode == 2 && n0 >= 1280) { r0 = (n0 < 1792) ? 1280 + 256 * ((n0 - 1280) / 128) + (n0 - 1280) % 128 : 1280 + 256 * ((n0 - 1792) / 128) + 128 + (n0 - 1792) % 128; }
    const int c = lane & 7;
#pragma unroll
    for (int j = 0; j < 4; ++j) { const int n = (lane >> 3) + 8 * j; const float* s = scr + (8 * c) * 33 + n;
        v4u o; o.x = pk2(s[0 * 33], s[1 * 33]); o.y = pk2(s[2 * 33], s[3 * 33]); o.z = pk2(s[4 * 33], s[5 * 33]); o.w = pk2(s[6 * 33], s[7 * 33]);
        *(v4u*)(t.WT + (size_t)(r0 + n) * t.K + k0 + 8 * c) = o; }
    __builtin_amdgcn_s_waitcnt(0xc07f); asm volatile("" ::: "memory");
}
__device__ __forceinline__ void transpose_matrix(const float* W, int K, int N, bf16* WT, int mode, const float* ks, int kmax, float* scr, int start, int stride, int lane) {
    const int npairs = (K / 64) * (N / 32) / 2;
    for (int p = start; p < npairs; p += stride) {
        TItem t0{W, WT, ks, K, N, mode, kmax, 2 * p}; TItem t1 = t0; t1.item = 2 * p + 1;
        f32x4 v0[8], v1[8];
        titem_load(t0, v0, lane); titem_load(t1, v1, lane);
        titem_finish(t0, v0, scr, lane);
        titem_finish(t1, v1, scr, lane);
    }
}
__device__ __forceinline__ void xrow_load(const float* xrow, f32x4 (&v)[4], int lane) {
    const f32x4* xr = (const f32x4*)xrow + lane;
#pragma unroll
    for (int j = 0; j < 4; ++j) v[j] = __builtin_nontemporal_load(xr + 64 * j);
}
__device__ __forceinline__ void xrow_finish(const f32x4 (&v)[4], bf16* orow, float* rss, int lane) {
    v2u* o8 = (v2u*)orow + lane; float s = 0.f;
#pragma unroll
    for (int j = 0; j < 4; ++j) { v2u o; o.x = pk2(v[j].x, v[j].y); o.y = pk2(v[j].z, v[j].w); o8[64 * j] = o;
        const float a = bflo(o.x), b = bfhi(o.x), c = bflo(o.y), d = bfhi(o.y); s += (a * a + b * b) + (c * c + d * d); }
    s = wave_sum(s); if (lane == 0) *rss = s;
}
__device__ __forceinline__ void prow_cvt(const float* pr, bf16* orow, int lane) {
    const f32x4 pv = __builtin_nontemporal_load((const f32x4*)pr + lane); v2u o; o.x = pk2(pv.x, pv.y); o.y = pk2(pv.z, pv.w); ((v2u*)orow)[lane] = o;
}
constexpr float ATT_C2 = 0.125f * 1.4426950408889634f;
struct MixIn { v4u k, gb, gu[3]; f32x4 rp[4]; };
struct MixPar { float kg[8], cw[3][8], cog[8]; };
__device__ __forceinline__ void mix_par(MixPar& p, const float* kg, const float* cw, const float* cog, int lane) {
    const int c = lane & 7, ch = lane * 8;
#pragma unroll
    for (int j = 0; j < 8; ++j) { p.kg[j] = kg[c * 8 + j]; p.cog[j] = cog[ch + j]; p.cw[0][j] = cw[ch + j]; p.cw[1][j] = cw[512 + ch + j]; p.cw[2][j] = cw[1024 + ch + j]; }
}
__device__ __forceinline__ void mix_load(int row, const bf16* Z, const float* rope, MixIn& r, int lane) {
    const int S = row < MP ? SP : SS, t = row & (S - 1);
    const bf16* zr = Z + (size_t)row * ZW; const int ch = lane * 8;
    r.k = *(const v4u*)(zr + 512 + (lane & 15) * 8);
    r.gb = *(const v4u*)(zr + 768 + ch); r.gu[1] = *(const v4u*)(zr + 1280 + ch);
    const v4u z4 = {0u, 0u, 0u, 0u};
    if (t > 0) r.gu[0] = *(const v4u*)(zr - ZW + 1280 + ch); else r.gu[0] = z4;
    if (t < S - 1) r.gu[2] = *(const v4u*)(zr + ZW + 1280 + ch); else r.gu[2] = z4;
    const int c = lane & 7, pos = (c >> 2) ? (t & 63) : (t >> 6);
    const f32x4* rp = (const f32x4*)(rope + (size_t)(pos * 16 + (c & 1) * 8) * 2);
#pragma unroll
    for (int j = 0; j < 4; ++j) r.rp[j] = rp[j];
}
struct RowX { v4u k, gb; f32x4 rp[4]; };
__device__ __forceinline__ void rowx_load(int row, const bf16* Z, const float* rope, RowX& r, int lane) {
    const int S = row < MP ? SP : SS, t = row & (S - 1);
    const bf16* zr = Z + (size_t)row * ZW;
    r.k = *(const v4u*)(zr + 512 + (lane & 15) * 8); r.gb = *(const v4u*)(zr + 768 + lane * 8);
    const int c = lane & 7, pos = (c >> 2) ? (t & 63) : (t >> 6);
    const f32x4* rp = (const f32x4*)(rope + (size_t)(pos * 16 + (c & 1) * 8) * 2);
#pragma unroll
    for (int j = 0; j < 4; ++j) r.rp[j] = rp[j];
}
__device__ __forceinline__ v4u gu_load(int row, bool valid, const bf16* Z, int lane) {
    const v4u z4 = {0u, 0u, 0u, 0u};
    return valid ? *(const v4u*)(Z + (size_t)row * ZW + 1280 + lane * 8) : z4;
}
__device__ __forceinline__ void mix_finish(int row, const MixIn& r, const MixPar& P, bf16* Z, bf16* MIX, int lane);
__device__ __forceinline__ void mix_finish_w(int row, const v4u gm, const v4u g0, const v4u gp, const RowX& x, const MixPar& P, bf16* Z, bf16* MIX, int lane) {
    MixIn r; r.k = x.k; r.gb = x.gb; r.gu[0] = gm; r.gu[1] = g0; r.gu[2] = gp;
#pragma unroll
    for (int j = 0; j < 4; ++j) r.rp[j] = x.rp[j];
    mix_finish(row, r, P, Z, MIX, lane);
}
__device__ __forceinline__ void mix_finish(int row, const MixIn& r, const MixPar& P, bf16* Z, bf16* MIX, int lane) {
    bf16* zr = Z + (size_t)row * ZW;
    const int c = lane & 7;
    float cs[8], sn[8];
#pragma unroll
    for (int j = 0; j < 4; ++j) { cs[2 * j] = r.rp[j].x; sn[2 * j] = r.rp[j].y; cs[2 * j + 1] = r.rp[j].z; sn[2 * j + 1] = r.rp[j].w; }
    const float sgn = (c & 2) ? 1.f : -1.f;
    {
        bf16* p = zr + 512 + (lane & 15) * 8;
        float v[8]; unpack8(r.k, v);
        float ss = 0.f;
#pragma unroll
        for (int j = 0; j < 8; ++j) ss += v[j] * v[j];
        const float rstd = rsqrtf(sum8(ss) * (1.f / 64.f) + EPS);
        float o[8];
#pragma unroll
        for (int j = 0; j < 8; ++j) v[j] = v[j] * rstd * P.kg[j];
#pragma unroll
        for (int j = 0; j < 8; ++j) { const float pr = DPPF(v[j], 0x4E); o[j] = v[j] * cs[j] + sgn * pr * sn[j]; }
        if (lane < 16) *(v4u*)p = pack8(o);
    }
    {
        const int ch = lane * 8;
        float gb[8], a[8], acc[8];
        unpack8(r.gb, gb);
#pragma unroll
        for (int j = 0; j < 8; ++j) acc[j] = 0.f;
#pragma unroll
        for (int d = 0; d < 3; ++d) { unpack8(r.gu[d], a);
#pragma unroll
            for (int j = 0; j < 8; ++j) acc[j] += P.cw[d][j] * a[j]; }
        float ss = 0.f;
#pragma unroll
        for (int j = 0; j < 8; ++j) { acc[j] *= gb[j]; ss += acc[j] * acc[j]; }
        const float rstd = rsqrtf(wave_sum(ss) * (1.f / 512.f) + EPS);
#pragma unroll
        for (int j = 0; j < 8; ++j) acc[j] = acc[j] * rstd * P.cog[j];
        *(v4u*)(MIX + (size_t)row * DMODEL + 512 + ch) = pack8(acc);
    }
}
__device__ __forceinline__ float silu_mul(float g, float u) { return g * __builtin_amdgcn_rcpf(1.f + __builtin_amdgcn_exp2f(-1.4426950408889634f * g)) * u; }

__global__ void __launch_bounds__(NWAVES * 64, 2) mega_fwd(Args a) {
    extern __shared__ __attribute__((aligned(16))) unsigned char lds[];
    cg::grid_group grid = cg::this_grid();
    if (threadIdx.x < 64) ((LAS unsigned*)((LAS unsigned char*)lds + MISC_OFF))[threadIdx.x] = 0u;
    __syncthreads();
    if (blockIdx.x == 0) { unsigned* cw = (unsigned*)((unsigned char*)a.p[19] + WS_CTL); for (int i = threadIdx.x; i < XCD_BAR_WORDS; i += NWAVES * 64) cw[i] = 0u; }
    XcdBarrier bar; bar.bar = (unsigned*)((unsigned char*)a.p[19] + WS_CTL); bar.x = 0; bar.st = (volatile LAS unsigned*)((LAS unsigned char*)lds + MISC_OFF);
#define GSYNC() xcd_barrier(bar)
#define PH_BEGIN \
    int tid_ = threadIdx.x; asm volatile("" : "+v"(tid_)); int zi = 0; asm volatile("" : "+s"(zi)); \
    const int tid = tid_, lane = tid & 63, wave = __builtin_amdgcn_readfirstlane(tid >> 6); \
    const int G = gridDim.x + zi, bx = blockIdx.x + zi; \
    const int vcu = (G % 8 == 0) ? (bx % 8) * (G / 8) + bx / 8 : bx; \
    const int gw = vcu * NWAVES + wave, NGW = G * NWAVES; \
    unsigned char* ws = (unsigned char*)a.p[19 + zi]; float* outp = (float*)a.p[18 + zi]; \
    float* rope = (float*)(ws + WS_ROPE); \
    float* RSS_IN = (float*)(ws + WS_RSS); float* RSS_FFN = RSS_IN + 2 * M; float* RSS_ATT = RSS_IN + 4 * M; \
    bf16* HA = (bf16*)outp; unsigned char* HBb = (unsigned char*)outp + (size_t)M * DMODEL * 2; bf16* A = (bf16*)(ws + WS_A); \
    unsigned char* wb = (l == 0) ? ws + WS_WIN : HBb;                        \
    bf16* Win = (bf16*)wb; bf16* Wout = (bf16*)(wb + (WS_WOUT - WS_WIN)); bf16* Wup = (bf16*)(wb + (WS_WUP - WS_WIN)); bf16* Wdown = (bf16*)(wb + (WS_WDOWN - WS_WIN)); \
    bf16* Wgate = (bf16*)(l == 0 ? ws + WS_WGATE : ws + WS_W2); bf16* Wproj = Wgate + (size_t)DMODEL * DMODEL; \
    bf16* RES = (l == 0) ? HA : A;  bf16* MIX = (l == 0) ? A : HA;            \
    bf16* BIG = (bf16*)(ws + WS_BIG); bf16* EB = (bf16*)(HBb + HB_E); bf16* P16 = (bf16*)(ws + WS_P16); \
    LAS unsigned char* ldsl = (LAS unsigned char*)lds; \
    (void)tid; (void)lane; (void)wave; (void)vcu; (void)gw; (void)NGW; (void)rope; (void)Win; (void)Wout; (void)Wup; (void)Wdown; (void)Wgate; (void)Wproj; (void)A; (void)BIG; (void)EB; (void)P16; (void)ldsl; (void)outp; (void)RSS_IN; (void)RSS_FFN; (void)RSS_ATT; (void)HA; (void)RES; (void)MIX;
#define IN(k) ((const float*)a.p[(k) + zi])
#if PROF_MASK
    unsigned long long tprev = __builtin_amdgcn_s_memrealtime(), tacc = 0;
#define STAMP(k) do { const unsigned long long tn_ = __builtin_amdgcn_s_memrealtime(); if ((PROF_MASK >> (k)) & 1) tacc += tn_ - tprev; tprev = tn_; } while (0)
#else
#define STAMP(k) do {} while (0)
#endif
#pragma unroll 1
    for (int l = 0; l < 2; ++l) {
        if (l == 0) {
#ifndef SKIP_P0
        { PH_BEGIN
            float* scr = (float*)(lds + wave * 16384);
            constexpr int I_IN = (DMODEL / 64) * (DIN / 32), I_OUT = (DMODEL / 64) * (DMODEL / 32), I_UP = (DMODEL / 64) * (NUP / 32), I_DOWN = (DFF / 64) * (DMODEL / 32), I_GATE = I_OUT, I_PROJ = (PLE / 64) * (DMODEL / 32);
            int cum = 0;
#pragma unroll 1
            for (int ly = 0; ly < 2; ++ly) {
                unsigned char* wb_ = ly == 0 ? ws + WS_WIN : HBb; bf16* wg_ = (bf16*)(ly == 0 ? ws + WS_WGATE : ws + WS_W2);
                transpose_matrix(IN(5) + (size_t)ly * DMODEL * DIN, DMODEL, DIN, (bf16*)wb_, 2, IN(4) + ly * DMODEL, DMODEL, scr, (gw + NGW - cum % NGW) % NGW, NGW, lane); cum += I_IN / 2;
                transpose_matrix(IN(11) + (size_t)ly * DMODEL * DMODEL, DMODEL, DMODEL, (bf16*)(wb_ + (WS_WOUT - WS_WIN)), 0, IN(9) + ly * 512, 512, scr, (gw + NGW - cum % NGW) % NGW, NGW, lane); cum += I_OUT / 2;
                transpose_matrix(IN(13) + (size_t)ly * DMODEL * NUP, DMODEL, NUP, (bf16*)(wb_ + (WS_WUP - WS_WIN)), 1, IN(12) + ly * DMODEL, DMODEL, scr, (gw + NGW - cum % NGW) % NGW, NGW, lane); cum += I_UP / 2;
                transpose_matrix(IN(15) + (size_t)ly * DFF * DMODEL, DFF, DMODEL, (bf16*)(wb_ + (WS_WDOWN - WS_WIN)), 0, nullptr, 0, scr, (gw + NGW - cum % NGW) % NGW, NGW, lane); cum += I_DOWN / 2;
                transpose_matrix(IN(16) + (size_t)ly * DMODEL * DMODEL, DMODEL, DMODEL, wg_, 0, nullptr, 0, scr, (gw + NGW - cum % NGW) % NGW, NGW, lane); cum += I_GATE / 2;
                transpose_matrix(IN(17) + (size_t)ly * PLE * DMODEL, PLE, DMODEL, wg_ + (size_t)DMODEL * DMODEL, 0, nullptr, 0, scr, (gw + NGW - cum % NGW) % NGW, NGW, lane); cum += I_PROJ / 2;
            }
            const float* xp = IN(0); const float* xs = IN(1); const float* pp_ = IN(2); const float* ps_ = IN(3);
            for (int m = gw; m < M; m += 4 * NGW) {
                f32x4 v[4][4];
#pragma unroll
                for (int q = 0; q < 4; ++q) { const int mm = m + q * NGW; xrow_load(mm < MP ? xp + (size_t)mm * DMODEL : xs + (size_t)(mm - MP) * DMODEL, v[q], lane); }
#pragma unroll
                for (int q = 0; q < 4; ++q) { const int mm = m + q * NGW; prow_cvt(mm < MP ? pp_ + (size_t)mm * PLE : ps_ + (size_t)(mm - MP) * PLE, P16 + (size_t)mm * PLE, lane); }
#pragma unroll
                for (int q = 0; q < 4; ++q) { const int mm = m + q * NGW; xrow_finish(v[q], HA + (size_t)mm * DMODEL, RSS_IN + mm, lane); }
            }
            { const int gt = bx * (NWAVES * 64) + tid;
                for (int i = gt; i < 5 * M; i += G * NWAVES * 64) RSS_IN[M + i] = 0.f;
                if (gt < 1024) { const int pos = gt >> 4, j = gt & 15; const float fr = __builtin_amdgcn_exp2f(-(float)j * 0.8304820237218406f); const float ang = (float)pos * fr;
                    const float rev = ang * 0.15915494309189535f; rope[2 * gt] = __builtin_amdgcn_cosf(rev); rope[2 * gt + 1] = __builtin_amdgcn_sinf(rev); } }
        }
#endif
        grid.sync();
        bar = xcd_barrier_post((unsigned*)((unsigned char*)a.p[19] + WS_CTL), (volatile LAS unsigned*)((LAS unsigned char*)lds + MISC_OFF));
        STAMP(0);
        }
#ifndef SKIP_P1
        { PH_BEGIN
            pg8::Gemm g{RES, Win, M, DIN, DMODEL}; pg8::StaticOrder S; S.init(M, DIN, G, bx);
            pg8::EpiStoreBf16 E{BIG, ZW, RSS_IN + (size_t)l * M, 1.f / 1024.f, 5};
            pg8::gemm_phase<pg8::EpiStoreBf16, pg8::StaticOrder, true, true>(ldsl, g, S, E);
        }
#endif
        GSYNC(); STAMP(1);
#ifndef SKIP_P2
        { PH_BEGIN
            const float* kg = IN(7) + l * 64; const float* cw = IN(8) + l * 3 * 512; const float* cog = IN(10) + l * 512;
            MixPar P; mix_par(P, kg, cw, cog, lane);
            {
                const int rpw = M / NGW, r0 = gw * rpw, S = r0 < MP ? SP : SS;
                v4u gm = gu_load(r0 - 1, (r0 & (S - 1)) != 0, BIG, lane), g0 = gu_load(r0, true, BIG, lane), g1 = gu_load(r0 + 1, true, BIG, lane), g2 = gu_load(r0 + 2, true, BIG, lane);
                RowX x0, x1; rowx_load(r0, BIG, rope, x0, lane); rowx_load(r0 + 1, BIG, rope, x1, lane);
#pragma unroll 1
                for (int i = 0; i < rpw; i += 2) { const int r = r0 + i; const bool more = i + 2 < rpw;
                    v4u n1 = g1, n2 = g2; RowX nx0 = x0, nx1 = x1;
                    if (more) { n1 = gu_load(r + 3, true, BIG, lane); n2 = gu_load(r + 4, ((r + 4) & (S - 1)) != 0, BIG, lane); rowx_load(r + 2, BIG, rope, nx0, lane); rowx_load(r + 3, BIG, rope, nx1, lane); }
                    mix_finish_w(r, gm, g0, g1, x0, P, BIG, MIX, lane); mix_finish_w(r + 1, g0, g1, g2, x1, P, BIG, MIX, lane);
                    gm = g1; g0 = g2; g1 = n1; g2 = n2; x0 = nx0; x1 = nx1; }
            }
        }
#endif
        GSYNC(); STAMP(2);
#ifndef SKIP_P3
        { PH_BEGIN
            const float* qg = IN(6) + l * 64;
            const int u0 = (int)(((long)vcu * 512) / G), u1 = (int)(((long)(vcu + 1) * 512) / G);
            for (int u = u0; u < u1; ++u) { const int bh = u >> 4, qb = u & 15; attn_body::attn_unit<8>((long)(bh >> 3) * SP, SP, bh & 7, qb, (const attn_body::bf16*)BIG, (attn_body::bf16*)MIX, RSS_ATT + (size_t)l * M, qg, rope, (char*)lds); }
            for (int u = u0; u < u1; ++u) { const int bh = u >> 3, qb = u & 7; attn_body::attn_unit<8>((long)MP + (long)(bh >> 3) * SS, SS, bh & 7, qb, (const attn_body::bf16*)BIG, (attn_body::bf16*)MIX, RSS_ATT + (size_t)l * M, qg, rope, (char*)lds); }
        }
#endif
        GSYNC(); STAMP(3);
#ifndef SKIP_P5
        { PH_BEGIN
            pg8::Gemm g{MIX, Wout, M, DMODEL, DMODEL}; pg8::StaticOrder S; S.init(M, DMODEL, G, bx);
            pg8::EpiRes<true> E{nullptr, nullptr, RES, nullptr, RES, nullptr, RSS_FFN + (size_t)l * M, RSS_ATT + (size_t)l * M};
            pg8::gemm_phase<pg8::EpiRes<true>, pg8::StaticOrder, true, true>(ldsl, g, S, E);
        }
#endif
        GSYNC(); STAMP(5);
#ifndef SKIP_P7
        { PH_BEGIN
            pg8::Gemm g{RES, Wup, M, NUP, DMODEL}; pg8::StaticOrder S; S.init(M, NUP, G, bx); S.rev = 1;
            pg8::EpiConvAct E{BIG, EB, IN(14) + (size_t)l * 3 * NUP, (LAS float*)(ldsl + HALO_OFF), RSS_FFN + (size_t)l * M};
            pg8::gemm_phase<pg8::EpiConvAct, pg8::StaticOrder, true, true>(ldsl, g, S, E);
        }
#endif
        GSYNC(); STAMP(7);
#ifndef SKIP_P9
        { PH_BEGIN
            pg8::StaticOrder S; S.init(M, DMODEL, G, bx);
            if (l == 1) { const float* pp_ = IN(2) + (size_t)MP * PLE; const float* ps_ = IN(3) + (size_t)MP * PLE;
                for (int m = gw; m < M; m += NGW) prow_cvt(m < MP ? pp_ + (size_t)m * PLE : ps_ + (size_t)(m - MP) * PLE, P16 + (size_t)m * PLE, lane); }
            {
                const float* cw = IN(14) + (size_t)l * 3 * NUP; pg8::Unit u;
                for (int i = 0; S.next(i, u); ++i)
#pragma unroll 1
                    for (int e = 0; e < 2; ++e) {
                        const int pm = u.pm, per = pm < 64 ? 16 : 8, ps = pm < 64 ? pm : pm - 64;
                        if (e == 0 ? (ps % per == 0) : (ps % per == per - 1)) continue;
                        const int row = e == 0 ? pm * 256 : pm * 256 + 255;
                        const bf16* ra = e == 0 ? EB + (size_t)((pm - 1) * 4 + 3) * NUP : EB + (size_t)(pm * 4 + 2) * NUP;
                        const bf16* rb = e == 0 ? EB + (size_t)(pm * 4 + 0) * NUP : EB + (size_t)(pm * 4 + 3) * NUP;
                        const bf16* rc = e == 0 ? EB + (size_t)(pm * 4 + 1) * NUP : EB + (size_t)((pm + 1) * 4 + 0) * NUP;
                        for (int idx = tid; idx < 704; idx += NWAVES * 64) { const int ch = idx * 4;
                            float fa[2][4], fb[2][4], fc[2][4]; f32x4 w[2][3];
#pragma unroll
                            for (int bj = 0; bj < 2; ++bj) { v2u x;
                                x = *(const v2u*)(ra + bj * DFF + ch); fa[bj][0] = bflo(x.x); fa[bj][1] = bfhi(x.x); fa[bj][2] = bflo(x.y); fa[bj][3] = bfhi(x.y);
                                x = *(const v2u*)(rb + bj * DFF + ch); fb[bj][0] = bflo(x.x); fb[bj][1] = bfhi(x.x); fb[bj][2] = bflo(x.y); fb[bj][3] = bfhi(x.y);
                                x = *(const v2u*)(rc + bj * DFF + ch); fc[bj][0] = bflo(x.x); fc[bj][1] = bfhi(x.x); fc[bj][2] = bflo(x.y); fc[bj][3] = bfhi(x.y);
#pragma unroll
                                for (int j = 0; j < 3; ++j) w[bj][j] = *(const f32x4*)(cw + j * NUP + bj * DFF + ch); }
                            float o[4];
#pragma unroll
                            for (int k = 0; k < 4; ++k) o[k] = silu_mul(w[0][0][k] * fa[0][k] + w[0][1][k] * fb[0][k] + w[0][2][k] * fc[0][k], w[1][0][k] * fa[1][k] + w[1][1][k] * fb[1][k] + w[1][2][k] * fc[1][k]);
                            v2u ov; ov.x = pk2(o[0], o[1]); ov.y = pk2(o[2], o[3]); *(v2u*)(BIG + (size_t)row * DFF + ch) = ov; }
                    }
                asm volatile("s_waitcnt vmcnt(0)" ::: "memory"); __syncthreads();
            }
        }
        { PH_BEGIN
            pg8::Gemm g{BIG, Wdown, M, DMODEL, DFF}; pg8::StaticOrder S; S.init(M, DMODEL, G, bx);
            pg8::EpiRes<false> E{nullptr, nullptr, RES, nullptr, RES, nullptr, nullptr, nullptr};
            pg8::gemm_phase<pg8::EpiRes<false>, pg8::StaticOrder, true, true>(ldsl, g, S, E);
        }
#endif
        GSYNC(); STAMP(9);
#ifndef SKIP_P10
        { PH_BEGIN
            pg8::StaticOrder S; S.init(M, DMODEL, G, bx); S.rev = 1;
            { pg8::Gemm g{P16, Wproj, M, DMODEL, PLE}; pg8::EpiStoreBf16 E{BIG, DMODEL, nullptr, 0.f, 1 << 20};
              pg8::gemm_phase<pg8::EpiStoreBf16, pg8::StaticOrder, true, true>(ldsl, g, S, E); }
            __threadfence_block(); __syncthreads();
            { pg8::Gemm g{RES, Wgate, M, DMODEL, DMODEL}; pg8::EpiRes<false> E{nullptr, nullptr, RES, BIG, l == 0 ? A : nullptr, l == 0 ? nullptr : outp, l == 0 ? RSS_IN + M : nullptr, nullptr};
              pg8::gemm_phase<pg8::EpiRes<false>, pg8::StaticOrder, true, true>(ldsl, g, S, E); }
        }
#endif
        if (l == 0) GSYNC();
        STAMP(10);
    }
#if PROF_MASK
    if (blockIdx.x == 0) { const unsigned long long t0 = __builtin_amdgcn_s_memrealtime(); while (__builtin_amdgcn_s_memrealtime() - t0 < tacc) __builtin_amdgcn_s_sleep(8); }
#endif
}

extern "C" void kernel_launch(void* const* d_in, const int* in_sizes, int n_in, void* d_out, int out_size, void* d_ws, size_t ws_size, hipStream_t stream) {
    static int grid = 0;
    if (grid == 0) {
        if (n_in != 18 || out_size != M * DMODEL || ws_size < WS_END) { fprintf(stderr, "kernel_launch: unexpected shapes (n_in %d out %d ws %zu)\n", n_in, out_size, ws_size); grid = -1; return; }
        int dev = 0, cus = 0, per_cu = 0;
        if (hipGetDevice(&dev) != hipSuccess || hipDeviceGetAttribute(&cus, hipDeviceAttributeMultiprocessorCount, dev) != hipSuccess) { grid = -1; return; }
        if (hipFuncSetAttribute((const void*)mega_fwd, hipFuncAttributeMaxDynamicSharedMemorySize, LDS_BYTES) != hipSuccess) { fprintf(stderr, "kernel_launch: hipFuncSetAttribute failed\n"); grid = -1; return; }
        if (hipOccupancyMaxActiveBlocksPerMultiprocessor(&per_cu, (const void*)mega_fwd, NWAVES * 64, LDS_BYTES) != hipSuccess || per_cu < 1) { fprintf(stderr, "kernel_launch: occupancy query gave %d\n", per_cu); (void)hipGetLastError(); grid = -1; return; }
        grid = cus * 1;
        if ((M / (grid * NWAVES)) % 4 != 0 || M % (grid * NWAVES) != 0 || SS % (M / (grid * NWAVES)) != 0) { fprintf(stderr, "kernel_launch: unsupported CU count %d\n", cus); grid = -1; return; }
        fprintf(stderr, "kernel_launch: grid %d (per_cu %d), ws %zu\n", grid, per_cu, ws_size);
    }
    if (grid < 0) return;
    Args a{};
    for (int i = 0; i < 18; ++i) a.p[i] = d_in[i];
    a.p[18] = d_out; a.p[19] = d_ws;
    void* args[] = {&a};
    hipError_t e = hipLaunchCooperativeKernel((void*)mega_fwd, dim3(grid), dim3(NWAVES * 64), args, LDS_BYTES, stream);
    if (e != hipSuccess) fprintf(stderr, "kernel_launch: cooperative launch failed: %s (grid %d)\n", hipGetErrorString(e), grid);
}
```
